# Optimizing an MI355X kernel written in HIP

```python
import math
import jax, jax.numpy as jnp
from jax import lax
import numpy as np

D_MODEL = 2048
BATCH = 2
SEQ = 4096
DEPTH = 1

N_DIFF_HEADS = 8
DIFF_QK_DIM = 64
DIFF_V_DIM = 2 * DIFF_QK_DIM
N_DSA_HEADS = 8
DSA_HEAD_DIM = 128
N_IDX_HEADS = 16
IDX_DIM = 64
INDEX_TOPK = 256
D_FF = ((8 * D_MODEL // 3 + 255) // 256) * 256
ROPE_THETA = 500000.0
ROPE_FRACTION = 4
Q_BLOCK = 128
ADA_CHUNKS = 6
RMS_EPS = 1e-6

DIFF_Q = N_DIFF_HEADS * 2 * DIFF_QK_DIM
DIFF_K = N_DIFF_HEADS * 2 * DIFF_QK_DIM
DIFF_V = N_DIFF_HEADS * DIFF_V_DIM
DSA_Q = N_DSA_HEADS * DSA_HEAD_DIM
DSA_K = DSA_HEAD_DIM
DSA_V = DSA_HEAD_DIM
IDX_Q = N_IDX_HEADS * IDX_DIM
IDX_K = IDX_DIM
IDX_W = N_IDX_HEADS
PROJ_SIZES = (DIFF_Q, DIFF_K, DIFF_V, DSA_Q, DSA_K, DSA_V, IDX_Q, IDX_K, IDX_W)
PROJ_TOTAL = sum(PROJ_SIZES)
MIX_WIDTH = DIFF_V + N_DSA_HEADS * DSA_HEAD_DIM

kernel_name = "hybrid_diffattn_dsa_swiglu_adaln"


def rms_norm(x, g):
    xf = x.astype(jnp.float32)
    y = xf * lax.rsqrt(jnp.mean(xf * xf, axis=-1, keepdims=True) + RMS_EPS)
    return (y * g.astype(jnp.float32)).astype(x.dtype)


def rope_tables(positions, rot_dim):
    inv_freq = ROPE_THETA ** (-(jnp.arange(0, rot_dim, 2, dtype=jnp.float32) / rot_dim))
    ang = positions.astype(jnp.float32)[..., None] * inv_freq
    return jnp.cos(ang), jnp.sin(ang)


def partial_rope(x, positions):
    d = x.shape[-1]
    rot = d // ROPE_FRACTION
    cos, sin = rope_tables(positions, rot)
    cos, sin = cos[:, :, None, :], sin[:, :, None, :]
    xr = x[..., :rot].astype(jnp.float32)
    x1, x2 = xr[..., : rot // 2], xr[..., rot // 2:]
    rotated = jnp.concatenate([x1 * cos - x2 * sin, x2 * cos + x1 * sin], axis=-1)
    return jnp.concatenate([rotated.astype(x.dtype), x[..., rot:]], axis=-1)


def differential_attention(q1, q2, k1, k2, v, lam):
    B, S, H, dq = q1.shape
    scale = dq ** -0.5
    key_pos = jnp.arange(S)

    def block(i):
        start = i * Q_BLOCK
        qb1 = lax.dynamic_slice_in_dim(q1, start, Q_BLOCK, axis=1)
        qb2 = lax.dynamic_slice_in_dim(q2, start, Q_BLOCK, axis=1)
        q_pos = start + jnp.arange(Q_BLOCK)
        mask = key_pos[None, :] <= q_pos[:, None]
        s1 = jnp.einsum('bqhd,bkhd->bhqk', qb1, k1).astype(jnp.float32) * scale
        s2 = jnp.einsum('bqhd,bkhd->bhqk', qb2, k2).astype(jnp.float32) * scale
        p1 = jax.nn.softmax(jnp.where(mask, s1, -jnp.inf), axis=-1)
        p2 = jax.nn.softmax(jnp.where(mask, s2, -jnp.inf), axis=-1)
        attn = p1 - lam * p2
        return jnp.einsum('bhqk,bkhd->bqhd', attn.astype(v.dtype), v)

    out = lax.map(block, jnp.arange(S // Q_BLOCK))
    return out.transpose(1, 0, 2, 3, 4).reshape(B, S, H, v.shape[-1])


def indexed_sparse_attention(q, k, v, iq, ik, iw, k_top):
    B, S, H, D = q.shape
    scale = D ** -0.5
    key_pos = jnp.arange(S)

    def block(i):
        start = i * Q_BLOCK
        qb = lax.dynamic_slice_in_dim(q, start, Q_BLOCK, axis=1)
        iqb = lax.dynamic_slice_in_dim(iq, start, Q_BLOCK, axis=1)
        iwb = lax.dynamic_slice_in_dim(iw, start, Q_BLOCK, axis=1)
        q_pos = start + jnp.arange(Q_BLOCK)
        mask = key_pos[None, :] <= q_pos[:, None]
        logits = jnp.einsum('bqhd,bkd->bqhk', iqb, ik).astype(jnp.float32)
        score = jnp.einsum('bqhk,bqh->bqk', jax.nn.relu(logits), iwb.astype(jnp.float32))
        score = jnp.where(mask[None], score, -jnp.inf)
        _, sel = lax.top_k(score, k_top)
        valid = sel <= q_pos[None, :, None]
        k_sel = jax.vmap(lambda kb, ib: kb[ib])(k, sel)
        v_sel = jax.vmap(lambda vb, ib: vb[ib])(v, sel)
        s = jnp.einsum('bqhd,bqkd->bhqk', qb, k_sel).astype(jnp.float32) * scale
        s = jnp.where(valid[:, None], s, -jnp.inf)
        p = jax.nn.softmax(s, axis=-1)
        return jnp.einsum('bhqk,bqkd->bqhd', p.astype(v.dtype), v_sel)

    out = lax.map(block, jnp.arange(S // Q_BLOCK))
    return out.transpose(1, 0, 2, 3, 4).reshape(B, S, H, D)


def setup_inputs(seed: int = 0) -> dict:
    key = jax.random.key(seed)
    ks = jax.random.split(key, 20)
    f32 = jnp.float32

    def nrm(k, shape, scale):
        return jax.random.normal(k, shape, f32) * scale

    def gain(k, shape):
        return 1.0 + 0.05 * jax.random.normal(k, shape, f32)

    x = jax.random.normal(ks[0], (BATCH, SEQ, D_MODEL), f32)
    c = jax.random.normal(ks[1], (BATCH, D_MODEL), f32)
    offset = jax.random.randint(ks[2], (BATCH, 1), 0, 1024, dtype=jnp.int32)
    positions = (jnp.arange(SEQ, dtype=jnp.int32)[None, :] + offset).astype(jnp.int32)
    return {
        "x": x,
        "c": c,
        "positions": positions,
        "w_ada": nrm(ks[3], (DEPTH, D_MODEL, ADA_CHUNKS * D_MODEL), 0.5 * D_MODEL ** -0.5),
        "b_ada": nrm(ks[4], (DEPTH, ADA_CHUNKS * D_MODEL), 0.02),
        "g_attn_pre": gain(ks[5], (DEPTH, D_MODEL)),
        "g_attn_post": gain(ks[6], (DEPTH, D_MODEL)),
        "g_ffn_pre": gain(ks[7], (DEPTH, D_MODEL)),
        "g_ffn_post": gain(ks[8], (DEPTH, D_MODEL)),
        "w_in": nrm(ks[9], (DEPTH, D_MODEL, PROJ_TOTAL), D_MODEL ** -0.5),
        "lambda_q1": nrm(ks[10], (DEPTH, DIFF_QK_DIM), 0.1),
        "lambda_k1": nrm(ks[11], (DEPTH, DIFF_QK_DIM), 0.1),
        "lambda_q2": nrm(ks[12], (DEPTH, DIFF_QK_DIM), 0.1),
        "lambda_k2": nrm(ks[13], (DEPTH, DIFF_QK_DIM), 0.1),
        "g_diff_sub": gain(ks[14], (DEPTH, DIFF_V_DIM)),
        "w_o": nrm(ks[15], (DEPTH, MIX_WIDTH, D_MODEL), MIX_WIDTH ** -0.5),
        "w_gate": nrm(ks[16], (DEPTH, D_MODEL, D_FF), D_MODEL ** -0.5),
        "w_up": nrm(ks[17], (DEPTH, D_MODEL, D_FF), D_MODEL ** -0.5),
        "w_down": nrm(ks[18], (DEPTH, D_FF, D_MODEL), D_FF ** -0.5),
    }


def reference(x, c, positions, w_ada, b_ada, g_attn_pre, g_attn_post, g_ffn_pre,
              g_ffn_post, w_in, lambda_q1, lambda_k1, lambda_q2, lambda_k2,
              g_diff_sub, w_o, w_gate, w_up, w_down):
    B, S, _ = x.shape
    k_top = min(INDEX_TOPK, S // 4)
    offsets = [0]
    for sz in PROJ_SIZES:
        offsets.append(offsets[-1] + sz)
    idx_w_scale = (N_IDX_HEADS ** -0.5) * (IDX_DIM ** -0.5)

    for l in range(DEPTH):
        mod = jax.nn.silu(c) @ w_ada[l] + b_ada[l]
        shift_a, scale_a, gate_a, shift_f, scale_f, gate_f = jnp.split(mod, ADA_CHUNKS, axis=-1)

        h = rms_norm(x, g_attn_pre[l]) * (1.0 + scale_a[:, None]) + shift_a[:, None]
        proj = h @ w_in[l]
        parts = [proj[..., offsets[i]:offsets[i + 1]] for i in range(len(PROJ_SIZES))]
        d_q, d_k, d_v, s_q, s_k, s_v, i_q, i_k, i_w = parts

        d_q = d_q.reshape(B, S, N_DIFF_HEADS, 2, DIFF_QK_DIM)
        d_k = d_k.reshape(B, S, N_DIFF_HEADS, 2, DIFF_QK_DIM)
        q1 = partial_rope(d_q[..., 0, :], positions)
        q2 = partial_rope(d_q[..., 1, :], positions)
        k1 = partial_rope(d_k[..., 0, :], positions)
        k2 = partial_rope(d_k[..., 1, :], positions)
        d_v = d_v.reshape(B, S, N_DIFF_HEADS, DIFF_V_DIM)
        lam_init = 0.8 - 0.6 * math.exp(-0.3 * l)
        lam = (jnp.exp(jnp.sum(lambda_q1[l].astype(jnp.float32) * lambda_k1[l].astype(jnp.float32)))
               - jnp.exp(jnp.sum(lambda_q2[l].astype(jnp.float32) * lambda_k2[l].astype(jnp.float32)))
               + lam_init)
        diff_out = differential_attention(q1, q2, k1, k2, d_v, lam)
        diff_out = rms_norm(diff_out, g_diff_sub[l]) * (1.0 - lam_init)
        diff_out = diff_out.reshape(B, S, DIFF_V)

        s_q = partial_rope(s_q.reshape(B, S, N_DSA_HEADS, DSA_HEAD_DIM), positions)
        s_k = partial_rope(s_k.reshape(B, S, 1, DSA_HEAD_DIM), positions)[:, :, 0]
        i_q = partial_rope(i_q.reshape(B, S, N_IDX_HEADS, IDX_DIM), positions)
        i_k = partial_rope(i_k.reshape(B, S, 1, IDX_DIM), positions)[:, :, 0]
        i_w = i_w * idx_w_scale
        dsa_out = indexed_sparse_attention(s_q, s_k, s_v, i_q, i_k, i_w, k_top)
        dsa_out = dsa_out.reshape(B, S, N_DSA_HEADS * DSA_HEAD_DIM)

        mixed = jnp.concatenate([diff_out, dsa_out], axis=-1) @ w_o[l]
        x = x + gate_a[:, None] * rms_norm(mixed, g_attn_post[l])

        h = rms_norm(x, g_ffn_pre[l]) * (1.0 + scale_f[:, None]) + shift_f[:, None]
        ff = (jax.nn.silu(h @ w_gate[l]) * (h @ w_up[l])) @ w_down[l]
        x = x + gate_f[:, None] * rms_norm(ff, g_ffn_post[l])

    return x
```

```cpp
#include <hip/hip_runtime.h>
#include <cstdio>
#include <cstdint>

typedef unsigned short bf16;
constexpr int BATCH = 2, SEQ = 4096, DM = 2048, M = BATCH * SEQ, NPROJ = 5456, FF = 5632, NADA = 6 * DM;
constexpr float RMS_EPS = 1e-6f;
constexpr float LOG2E = 1.4426950408889634f;
constexpr float C2D = 0.125f * LOG2E;
constexpr float C2S = 0.08838834764831845f * LOG2E;
constexpr float IDXW_SCALE = 0.03125f;

constexpr size_t MiB = 1u << 20;
constexpr size_t WS_CTL = 0, WS_MODP = 1 * MiB, WS_MOD = 3 * MiB, WS_ROPE = 4 * MiB, WS_WI = 6 * MiB, WS_KI = 7 * MiB, WS_KS = 8 * MiB, WS_VS = 10 * MiB;
constexpr size_t WS_WIN = 16 * MiB, WS_WO = 38 * MiB, WS_WGU = 46 * MiB, WS_WD = 90 * MiB;
constexpr size_t WS_MIX = 112 * MiB, WS_QD = 144 * MiB, WS_KD = 160 * MiB, WS_VD = 176 * MiB, WS_QS = 192 * MiB, WS_QI = 208 * MiB, WS_O1 = 224 * MiB, WS_O2 = 240 * MiB;
constexpr size_t WS_XN = 256 * MiB, WS_SCORES = 256 * MiB, WS_MIXOUT = 288 * MiB, WS_FFO = 288 * MiB, WS_ACT = 144 * MiB, WS_END = 384 * MiB;

__device__ __forceinline__ float bf2f(bf16 v) { return __uint_as_float((unsigned)v << 16); }
__device__ __forceinline__ bf16 f2bf(float f) { unsigned u = __float_as_uint(f); return (bf16)((u + 0x7fffu + ((u >> 16) & 1u)) >> 16); }

namespace nv {
__device__ __forceinline__ float block_sum(float v, float* red) {
    const int tid = threadIdx.x;
    red[tid] = v; __syncthreads();
    for (int s = 128; s > 0; s >>= 1) { if (tid < s) red[tid] += red[tid + s]; __syncthreads(); }
    const float r = red[0]; __syncthreads(); return r;
}
__device__ __forceinline__ float block_max(float v, float* red) {
    const int tid = threadIdx.x;
    red[tid] = v; __syncthreads();
    for (int s = 128; s > 0; s >>= 1) { if (tid < s) red[tid] = fmaxf(red[tid], red[tid + s]); __syncthreads(); }
    const float r = red[0]; __syncthreads(); return r;
}

__global__ void __launch_bounds__(256) ada(const float* c, const float* w, const float* bias, float* mod) {
    __shared__ float sc[DM];
    const int b = blockIdx.y;
    for (int k = threadIdx.x; k < DM; k += 256) { const float v = c[b * DM + k]; sc[k] = v / (1.f + expf(-v)); }
    __syncthreads();
    const int j = blockIdx.x * 256 + threadIdx.x;
    float acc = 0.f;
    for (int k = 0; k < DM; ++k) acc += sc[k] * w[(size_t)k * NADA + j];
    mod[b * NADA + j] = acc + bias[j];
}
__global__ void __launch_bounds__(256) rope_tab(const int* pos, float* rope) {
    const int g = blockIdx.x * 256 + threadIdx.x; if (g >= M * 24) return;
    const int m = g / 24, i = g % 24; const float p = (float)pos[m];
    if (i < 8) { const float inv = powf(500000.f, -((float)(2 * i) / 16.f)); const float a = p * inv; rope[m * 48 + i] = cosf(a); rope[m * 48 + 8 + i] = sinf(a); }
    else { const int k = i - 8; const float inv = powf(500000.f, -((float)(2 * k) / 32.f)); const float a = p * inv; rope[m * 48 + 16 + k] = cosf(a); rope[m * 48 + 32 + k] = sinf(a); }
}
__global__ void __launch_bounds__(256) norm_mod(const float* x, const float* g, const float* mod, int sh_off, int sc_off, bf16* out) {
    __shared__ float red[256];
    const int m = blockIdx.x, b = m / SEQ, tid = threadIdx.x; const float* xr = x + (size_t)m * DM;
    float v[8], s = 0.f;
    for (int i = 0; i < 8; ++i) { v[i] = xr[tid + 256 * i]; s += v[i] * v[i]; }
    const float rstd = rsqrtf(block_sum(s, red) / DM + RMS_EPS);
    for (int i = 0; i < 8; ++i) { const int j = tid + 256 * i; out[(size_t)m * DM + j] = f2bf(v[i] * rstd * g[j] * (1.f + mod[b * NADA + sc_off + j]) + mod[b * NADA + sh_off + j]); }
}

template <class Epi, bool DUAL>
__global__ void __launch_bounds__(256) gemm(const bf16* A, const float* W, const float* W2, int N, int K, int ldw, Epi E) {
    __shared__ float As[16][65], Bs[16][65], Bs2[DUAL ? 16 : 1][65], Ct[64][65];
    const int tid = threadIdx.x, tx = tid & 15, ty = tid >> 4, m0 = blockIdx.y * 64, n0 = blockIdx.x * 64;
    float acc[4][4], acc2[4][4];
    for (int i = 0; i < 4; ++i) for (int j = 0; j < 4; ++j) { acc[i][j] = 0.f; acc2[i][j] = 0.f; }
    for (int k0 = 0; k0 < K; k0 += 16) {
        for (int e = 0; e < 4; ++e) {
            const int idx = tid * 4 + e; const int r = idx >> 4, kk = idx & 15;
            As[kk][r] = bf2f(A[(size_t)(m0 + r) * K + k0 + kk]);
            const int kb = idx >> 6, nn = idx & 63; const int n = n0 + nn;
            Bs[kb][nn] = (n < N) ? bf2f(f2bf(W[(size_t)(k0 + kb) * ldw + n])) : 0.f;
            if (DUAL) Bs2[kb][nn] = (n < N) ? bf2f(f2bf(W2[(size_t)(k0 + kb) * ldw + n])) : 0.f;
        }
        __syncthreads();
        for (int kk = 0; kk < 16; ++kk) {
            float a[4], b[4], b2[4];
            for (int i = 0; i < 4; ++i) a[i] = As[kk][ty * 4 + i];
            for (int j = 0; j < 4; ++j) { b[j] = Bs[kk][tx * 4 + j]; if (DUAL) b2[j] = Bs2[kk][tx * 4 + j]; }
            for (int i = 0; i < 4; ++i) for (int j = 0; j < 4; ++j) { acc[i][j] += a[i] * b[j]; if (DUAL) acc2[i][j] += a[i] * b2[j]; }
        }
        __syncthreads();
    }
    for (int i = 0; i < 4; ++i) for (int j = 0; j < 4; ++j) Ct[ty * 4 + i][tx * 4 + j] = acc[i][j];
    __syncthreads();
    for (int i = 0; i < 4; ++i) for (int j = 0; j < 4; ++j) { const int n = n0 + tx * 4 + j; if (n < N) E(m0 + ty * 4 + i, n, Ct, ty * 4 + i, tx * 4 + j, acc2[i][j]); }
}
struct EProj {
    bf16 *Qd, *Kd, *Vd, *Qs, *Ks, *Vs, *Qi, *Ki; float* Wi; const float* rope;
    __device__ float r16(int m, float v, const float (*Ct)[65], int lm, int ln) const {
        const int d = ln; if (d >= 16) return v; const int i = d & 7; const float c = rope[m * 48 + i], s = rope[m * 48 + 8 + i];
        return d < 8 ? v * c - Ct[lm][ln + 8] * s : v * c + Ct[lm][ln - 8] * s; }
    __device__ float r32(int m, float v, const float (*Ct)[65], int lm, int ln, int d) const {
        if (d >= 32) return v; const int i = d & 15; const float c = rope[m * 48 + 16 + i], s = rope[m * 48 + 32 + i];
        return d < 16 ? v * c - Ct[lm][ln + 16] * s : v * c + Ct[lm][ln - 16] * s; }
    __device__ void operator()(int m, int n, const float (*Ct)[65], int lm, int ln, float) const {
        const float v = Ct[lm][ln];
        if (n < 1024) Qd[(size_t)m * 1024 + n] = f2bf(r16(m, v, Ct, lm, ln) * C2D);
        else if (n < 2048) Kd[(size_t)m * 1024 + n - 1024] = f2bf(r16(m, v, Ct, lm, ln));
        else if (n < 3072) Vd[(size_t)m * 1024 + n - 2048] = f2bf(v);
        else if (n < 4096) Qs[(size_t)m * 1024 + n - 3072] = f2bf(r32(m, v, Ct, lm, ln, (n - 3072) & 127) * C2S);
        else if (n < 4224) Ks[(size_t)m * 128 + n - 4096] = f2bf(r32(m, v, Ct, lm, ln, n - 4096));
        else if (n < 4352) Vs[(size_t)m * 128 + n - 4224] = f2bf(v);
        else if (n < 5376) Qi[(size_t)m * 1024 + n - 4352] = f2bf(r16(m, v, Ct, lm, ln));
        else if (n < 5440) Ki[(size_t)m * 64 + n - 5376] = f2bf(r16(m, v, Ct, lm, ln));
        else Wi[(size_t)m * 16 + n - 5440] = v * IDXW_SCALE;
    }
};
struct EF32 { float* out; int ldc; __device__ void operator()(int m, int n, const float (*Ct)[65], int lm, int ln, float) const { out[(size_t)m * ldc + n] = Ct[lm][ln]; } };
struct ESwi { bf16* out; int ldc; __device__ void operator()(int m, int n, const float (*Ct)[65], int lm, int ln, float u) const { const float g = Ct[lm][ln]; out[(size_t)m * ldc + n] = f2bf(g / (1.f + expf(-g)) * u); } };

__global__ void __launch_bounds__(256) diffattn(const bf16* Qd, const bf16* Kd, const bf16* Vd, bf16* O1, bf16* O2) {
    __shared__ float s[2][SEQ]; __shared__ float q[2][64]; __shared__ float red[256]; __shared__ float part[2][256];
    const int t = blockIdx.x % SEQ, h = (blockIdx.x / SEQ) % 8, b = blockIdx.x / (SEQ * 8), tid = threadIdx.x;
    const size_t row0 = (size_t)b * SEQ;
    if (tid < 128) q[tid >> 6][tid & 63] = bf2f(Qd[(row0 + t) * 1024 + h * 128 + tid]);
    __syncthreads();
    float mx0 = -INFINITY, mx1 = -INFINITY;
    for (int j = tid; j <= t; j += 256) {
        const bf16* k = Kd + (row0 + j) * 1024 + h * 128; float d0 = 0.f, d1 = 0.f;
        for (int d = 0; d < 64; ++d) { d0 += q[0][d] * bf2f(k[d]); d1 += q[1][d] * bf2f(k[64 + d]); }
        s[0][j] = d0; s[1][j] = d1; mx0 = fmaxf(mx0, d0); mx1 = fmaxf(mx1, d1);
    }
    mx0 = block_max(mx0, red); mx1 = block_max(mx1, red);
    float l0 = 0.f, l1 = 0.f;
    for (int j = tid; j <= t; j += 256) { const float e0 = exp2f(s[0][j] - mx0), e1 = exp2f(s[1][j] - mx1); s[0][j] = e0; s[1][j] = e1; l0 += e0; l1 += e1; }
    l0 = block_sum(l0, red); l1 = block_sum(l1, red);
    const int d = tid & 127, half = tid >> 7; float a0 = 0.f, a1 = 0.f;
    for (int j = half; j <= t; j += 2) { const float v = bf2f(Vd[(row0 + j) * 1024 + h * 128 + d]); a0 += s[0][j] * v; a1 += s[1][j] * v; }
    part[0][tid] = a0; part[1][tid] = a1; __syncthreads();
    if (tid < 128) { O1[(row0 + t) * 1024 + h * 128 + d] = f2bf((part[0][tid] + part[0][tid + 128]) / l0); O2[(row0 + t) * 1024 + h * 128 + d] = f2bf((part[1][tid] + part[1][tid + 128]) / l1); }
}
__device__ __forceinline__ float lam_value(const float* lq1, const float* lk1, const float* lq2, const float* lk2) {
    float a = 0.f, b = 0.f; for (int i = 0; i < 64; ++i) { a += lq1[i] * lk1[i]; b += lq2[i] * lk2[i]; } return expf(a) - expf(b) + 0.2f;
}
__global__ void __launch_bounds__(128) combine(const bf16* O1, const bf16* O2, const float* lq1, const float* lk1, const float* lq2, const float* lk2, const float* g, bf16* MIX) {
    __shared__ float red[128];
    const int m = blockIdx.x >> 3, h = blockIdx.x & 7, d = threadIdx.x;
    const float lam = lam_value(lq1, lk1, lq2, lk2);
    const float v = bf2f(O1[(size_t)m * 1024 + h * 128 + d]) - lam * bf2f(O2[(size_t)m * 1024 + h * 128 + d]);
    red[d] = v * v; __syncthreads();
    for (int s = 64; s > 0; s >>= 1) { if (d < s) red[d] += red[d + s]; __syncthreads(); }
    const float rstd = rsqrtf(red[0] / 128.f + RMS_EPS);
    MIX[(size_t)m * 2048 + h * 128 + d] = f2bf(v * rstd * g[d] * 0.8f);
}
__global__ void __launch_bounds__(256) dsa(const bf16* Qi, const bf16* Ki, const float* Wi, const bf16* Qs, const bf16* Ks, const bf16* Vs, bf16* MIX) {
    __shared__ float sc[SEQ]; __shared__ unsigned short si[SEQ]; __shared__ float iq[16][64]; __shared__ float w[16]; __shared__ float qs[8][128]; __shared__ float ps[8][256];
    const int t = blockIdx.x % SEQ, b = blockIdx.x / SEQ, tid = threadIdx.x; const size_t row0 = (size_t)b * SEQ, m = row0 + t;
    for (int i = tid; i < 1024; i += 256) { iq[i >> 6][i & 63] = bf2f(Qi[m * 1024 + i]); qs[i >> 7][i & 127] = bf2f(Qs[m * 1024 + i]); }
    if (tid < 16) w[tid] = Wi[m * 16 + tid];
    __syncthreads();
    for (int j = tid; j < SEQ; j += 256) {
        float score = -INFINITY;
        if (j <= t) {
            float k[64]; const bf16* kp = Ki + (row0 + j) * 64;
            for (int d = 0; d < 64; ++d) k[d] = bf2f(kp[d]);
            score = 0.f;
            for (int h = 0; h < 16; ++h) { float dot = 0.f; for (int d = 0; d < 64; ++d) dot += iq[h][d] * k[d]; score += w[h] * fmaxf(dot, 0.f); }
        }
        sc[j] = score; si[j] = (unsigned short)j;
    }
    __syncthreads();
    for (int k = 2; k <= SEQ; k <<= 1)
        for (int j = k >> 1; j > 0; j >>= 1) {
            for (int i = tid; i < SEQ; i += 256) {
                const int x = i ^ j;
                if (x > i) {
                    const float sa = sc[i], sb = sc[x]; const unsigned short ia = si[i], ib = si[x];
                    const bool a_first = (sa > sb) || (sa == sb && ia < ib);
                    const bool up = ((i & k) == 0);
                    if (up ? !a_first : a_first) { sc[i] = sb; sc[x] = sa; si[i] = ib; si[x] = ia; }
                }
            }
            __syncthreads();
        }
    {   const int idx = si[tid]; const bool valid = idx <= t; const bf16* kp = Ks + (row0 + idx) * 128;
        float dot[8]; for (int h = 0; h < 8; ++h) dot[h] = 0.f;
        for (int d = 0; d < 128; ++d) { const float kv = bf2f(kp[d]); for (int h = 0; h < 8; ++h) dot[h] += qs[h][d] * kv; }
        for (int h = 0; h < 8; ++h) ps[h][tid] = valid ? dot[h] : -INFINITY; }
    __syncthreads();
    if (tid < 8) { float mx = -INFINITY; for (int k = 0; k < 256; ++k) mx = fmaxf(mx, ps[tid][k]); float l = 0.f; for (int k = 0; k < 256; ++k) { const float e = exp2f(ps[tid][k] - mx); ps[tid][k] = e; l += e; }
        const float il = 1.f / l; for (int k = 0; k < 256; ++k) ps[tid][k] *= il; }
    __syncthreads();
    {   const int d = tid & 127, hg = tid >> 7; float a[4] = {0.f, 0.f, 0.f, 0.f};
        for (int k = 0; k < 256; ++k) { const float v = bf2f(Vs[(row0 + si[k]) * 128 + d]); for (int hh = 0; hh < 4; ++hh) a[hh] += ps[hg * 4 + hh][k] * v; }
        for (int hh = 0; hh < 4; ++hh) MIX[m * 2048 + 1024 + (hg * 4 + hh) * 128 + d] = f2bf(a[hh]); }
}
__global__ void __launch_bounds__(256) post1(const float* mixout, const float* x, const float* mod, const float* g_post, const float* g_pre2, float* x1, bf16* xn2) {
    __shared__ float red[256];
    const int m = blockIdx.x, b = m / SEQ, tid = threadIdx.x; const float* md = mod + b * NADA;
    float v[8], s = 0.f;
    for (int i = 0; i < 8; ++i) { v[i] = mixout[(size_t)m * DM + tid + 256 * i]; s += v[i] * v[i]; }
    const float rstd = rsqrtf(block_sum(s, red) / DM + RMS_EPS);
    float s2 = 0.f;
    for (int i = 0; i < 8; ++i) { const int j = tid + 256 * i; v[i] = x[(size_t)m * DM + j] + md[2 * DM + j] * (v[i] * rstd * g_post[j]); s2 += v[i] * v[i]; x1[(size_t)m * DM + j] = v[i]; }
    const float rstd2 = rsqrtf(block_sum(s2, red) / DM + RMS_EPS);
    for (int i = 0; i < 8; ++i) { const int j = tid + 256 * i; xn2[(size_t)m * DM + j] = f2bf(v[i] * rstd2 * g_pre2[j] * (1.f + md[4 * DM + j]) + md[3 * DM + j]); }
}
__global__ void __launch_bounds__(256) post2(const float* ff, const float* mod, const float* g, float* out) {
    __shared__ float red[256];
    const int m = blockIdx.x, b = m / SEQ, tid = threadIdx.x; const float* md = mod + b * NADA;
    float v[8], s = 0.f;
    for (int i = 0; i < 8; ++i) { v[i] = ff[(size_t)m * DM + tid + 256 * i]; s += v[i] * v[i]; }
    const float rstd = rsqrtf(block_sum(s, red) / DM + RMS_EPS);
    for (int i = 0; i < 8; ++i) { const int j = tid + 256 * i; out[(size_t)m * DM + j] += md[5 * DM + j] * (v[i] * rstd * g[j]); }
}
}

extern "C" void kernel_launch(void* const* d_in, const int* in_sizes, int n_in, void* d_out, int out_size, void* d_ws, size_t ws_size, hipStream_t stream) {
    if (n_in != 19 || out_size != M * DM || ws_size < WS_END) { fprintf(stderr, "kernel_launch: unexpected shapes (n_in %d out %d ws %zu)\n", n_in, out_size, ws_size); return; }
    const float* x = (const float*)d_in[0]; const float* c = (const float*)d_in[1]; const int* pos = (const int*)d_in[2];
    const float* w_ada = (const float*)d_in[3]; const float* b_ada = (const float*)d_in[4];
    const float* g_attn_pre = (const float*)d_in[5]; const float* g_attn_post = (const float*)d_in[6]; const float* g_ffn_pre = (const float*)d_in[7]; const float* g_ffn_post = (const float*)d_in[8];
    const float* w_in = (const float*)d_in[9]; const float* lq1 = (const float*)d_in[10]; const float* lk1 = (const float*)d_in[11]; const float* lq2 = (const float*)d_in[12]; const float* lk2 = (const float*)d_in[13];
    const float* g_diff = (const float*)d_in[14]; const float* w_o = (const float*)d_in[15]; const float* w_gate = (const float*)d_in[16]; const float* w_up = (const float*)d_in[17]; const float* w_down = (const float*)d_in[18];
    unsigned char* ws = (unsigned char*)d_ws; float* out = (float*)d_out;
    float* MOD = (float*)(ws + WS_MOD); float* ROPE = (float*)(ws + WS_ROPE); float* WI = (float*)(ws + WS_WI);
    bf16 *KI = (bf16*)(ws + WS_KI), *KS = (bf16*)(ws + WS_KS), *VS = (bf16*)(ws + WS_VS), *MIX = (bf16*)(ws + WS_MIX), *QD = (bf16*)(ws + WS_QD), *KD = (bf16*)(ws + WS_KD), *VD = (bf16*)(ws + WS_VD);
    bf16 *QS = (bf16*)(ws + WS_QS), *QI = (bf16*)(ws + WS_QI), *O1 = (bf16*)(ws + WS_O1), *O2 = (bf16*)(ws + WS_O2), *XN = (bf16*)(ws + WS_XN), *ACT = (bf16*)(ws + WS_ACT);
    float* MIXOUT = (float*)(ws + WS_MIXOUT); float* FFO = (float*)(ws + WS_FFO);

    nv::ada<<<dim3(NADA / 256, BATCH), 256, 0, stream>>>(c, w_ada, b_ada, MOD);
    nv::rope_tab<<<(M * 24 + 255) / 256, 256, 0, stream>>>(pos, ROPE);
    nv::norm_mod<<<M, 256, 0, stream>>>(x, g_attn_pre, MOD, 0, DM, XN);
    nv::EProj ep{QD, KD, VD, QS, KS, VS, QI, KI, WI, ROPE};
    nv::gemm<nv::EProj, false><<<dim3((NPROJ + 63) / 64, M / 64), 256, 0, stream>>>(XN, w_in, nullptr, NPROJ, DM, NPROJ, ep);
    nv::diffattn<<<BATCH * 8 * SEQ, 256, 0, stream>>>(QD, KD, VD, O1, O2);
    nv::combine<<<M * 8, 128, 0, stream>>>(O1, O2, lq1, lk1, lq2, lk2, g_diff, MIX);
    nv::dsa<<<M, 256, 0, stream>>>(QI, KI, WI, QS, KS, VS, MIX);
    nv::gemm<nv::EF32, false><<<dim3(DM / 64, M / 64), 256, 0, stream>>>(MIX, w_o, nullptr, DM, DM, DM, nv::EF32{MIXOUT, DM});
    nv::post1<<<M, 256, 0, stream>>>(MIXOUT, x, MOD, g_attn_post, g_ffn_pre, out, XN);
    nv::gemm<nv::ESwi, true><<<dim3(FF / 64, M / 64), 256, 0, stream>>>(XN, w_gate, w_up, FF, DM, FF, nv::ESwi{ACT, FF});
    nv::gemm<nv::EF32, false><<<dim3(DM / 64, M / 64), 256, 0, stream>>>(ACT, w_down, nullptr, DM, FF, DM, nv::EF32{FFO, DM});
    nv::post2<<<M, 256, 0, stream>>>(FFO, MOD, g_ffn_post, out);
}
```

```cpp
#include <hip/hip_runtime.h>
#include <hip/hip_bf16.h>
#include <cstdio>
#include <cstdint>
#include <cmath>

constexpr int BATCH = 2, SEQ = 4096, DM = 2048, M = BATCH * SEQ, NPROJ = 5456, NPROJ_PAD = 5632, FF = 5632, NADA = 6 * DM;
constexpr float RMS_EPS = 1e-6f;
constexpr float LOG2E = 1.4426950408889634f;
constexpr float C2D = 0.125f * LOG2E;
constexpr float C2S = 0.08838834764831845f * LOG2E;
constexpr float IDXW_SCALE = 0.03125f;
constexpr int ADA_KC = 16;

constexpr size_t MiB = 1u << 20;
constexpr size_t WS_CTL = 0, CTL_ZERO_BYTES = 64 * 1024, WS_MODP = 1 * MiB, WS_MOD = 3 * MiB, WS_ROPE = 4 * MiB, WS_WI = 6 * MiB, WS_KI = 7 * MiB, WS_KS = 8 * MiB, WS_VS = 10 * MiB, WS_KS8 = 12 * MiB, WS_VS8 = 13 * MiB;
constexpr size_t WS_WIN = 16 * MiB, WS_WO = 38 * MiB, WS_WGU = 46 * MiB, WS_WD = 90 * MiB;
constexpr size_t WS_MIX = 112 * MiB, WS_QD = 144 * MiB, WS_KD = 160 * MiB, WS_VD = 176 * MiB, WS_QS = 192 * MiB, WS_QI = 208 * MiB, WS_O1 = 224 * MiB, WS_O2 = 240 * MiB;
constexpr size_t WS_XN = 256 * MiB, WS_SCORES = 256 * MiB, WS_MIXOUT = 288 * MiB, WS_FFO = 288 * MiB, WS_ACT = 144 * MiB, WS_END = 384 * MiB;
constexpr int CW_TMO = 0, CW_CODE = 1, CW_BAR = 4096;
#define GAS __attribute__((address_space(1)))
#define LAS __attribute__((address_space(3)))
typedef unsigned short bf16;
typedef unsigned v4u __attribute__((ext_vector_type(4)));
typedef float f32x4 __attribute__((ext_vector_type(4)));
typedef short bf16x8 __attribute__((ext_vector_type(8)));
typedef GAS unsigned gu32;
typedef GAS unsigned long long gu64;
#define RLX_AGENT __ATOMIC_RELAXED, __HIP_MEMORY_SCOPE_AGENT
#define LDS_WAIT() asm volatile("s_waitcnt lgkmcnt(0)" ::: "memory")
#define VM_WAIT() asm volatile("s_waitcnt vmcnt(0)" ::: "memory")
__device__ __forceinline__ unsigned long long rt() { return __builtin_amdgcn_s_memrealtime(); }
__device__ __forceinline__ unsigned f2bf(float f) { unsigned u = __builtin_bit_cast(unsigned, f); return (u + 0x7fffu + ((u >> 16) & 1u)) >> 16; }
__device__ __forceinline__ unsigned pk2(float lo, float hi) { return f2bf(lo) | (f2bf(hi) << 16); }

#define XB_TMO      128
#define XB_XCNT(j)  (256  + 64 * (j))
#define XB_XSUB(j)  (1280 + 64 * (j))
#define XB_XGEN(j)  (2304 + 64 * (j))
#define XB_TOP      3328
#define XB_TOPGEN   3392
#define XCD_BAR_WORDS 3456
#define XB_SPIN_CAP (1u << 18)

__device__ __forceinline__ unsigned xb_ld(unsigned* p)              { return __hip_atomic_load(p, __ATOMIC_RELAXED, __HIP_MEMORY_SCOPE_AGENT); }
__device__ __forceinline__ unsigned xb_add(unsigned* p, unsigned v) { return __hip_atomic_fetch_add(p, v, __ATOMIC_RELAXED, __HIP_MEMORY_SCOPE_AGENT); }
__device__ __forceinline__ unsigned xb_xcc_id() { return (unsigned)__builtin_amdgcn_s_getreg((3 << 11) | 20) & 0xFu; }
#define XB_SPIN(cond, bar) do { unsigned _sp = 0; while (cond) { __builtin_amdgcn_s_sleep(1); \
    if ((++_sp & 255u) == 0u) { if (xb_ld(&(bar)[XB_TMO])) break; if (_sp > XB_SPIN_CAP) { atomicAdd(&(bar)[XB_TMO], 1u); break; } } } } while (0)

struct XcdBarrier {
    unsigned* bar; unsigned x;
    volatile LAS unsigned* st;
};

__device__ __forceinline__ XcdBarrier xcd_barrier_post(unsigned* bar, volatile LAS unsigned* st) {
    XcdBarrier b; b.bar = bar; b.x = xb_xcc_id(); b.st = st;
    if (threadIdx.x == 0) (void)xb_add(&bar[XB_XCNT(b.x)], 1u);
    return b;
}
__device__ __forceinline__ void xcd_barrier_complete(unsigned* bar, unsigned x, unsigned& nloc, unsigned& nx) {
    const unsigned G = gridDim.x * gridDim.y * gridDim.z;
    unsigned sum, cnt, mine, sp = 0u;
    for (;;) {
        sum = 0u; cnt = 0u; mine = 0u;
#pragma unroll
        for (unsigned j = 0; j < 16; ++j) { const unsigned c = xb_ld(&bar[XB_XCNT(j)]); sum += c; cnt += (c > 0u) ? 1u : 0u; mine = (j == x) ? c : mine; }
        if (sum == G) break;
        __builtin_amdgcn_s_sleep(1);
        if ((++sp & 255u) == 0u) { if (xb_ld(&bar[XB_TMO])) break; if (sp > XB_SPIN_CAP) { atomicAdd(&bar[XB_TMO], 1u); break; } }
    }
    nloc = mine > 0u ? mine : 1u; nx = cnt > 0u ? cnt : 1u;
}

__device__ __forceinline__ void xcd_barrier(const XcdBarrier& b) {
    asm volatile("s_waitcnt vmcnt(0)" ::: "memory");
    __syncthreads();
    if (threadIdx.x == 0) {
        unsigned* bar = b.bar;
        __builtin_amdgcn_s_waitcnt(0);
        unsigned nloc = b.st[0], nx = b.st[1];
        if (nloc == 0u) { xcd_barrier_complete(bar, b.x, nloc, nx); b.st[0] = nloc; b.st[1] = nx; }
        const unsigned old = xb_add(&bar[XB_XSUB(b.x)], 1u);
        const unsigned gen = old / nloc;
        if (old + 1u == (gen + 1u) * nloc) {
            __builtin_amdgcn_fence(__ATOMIC_RELEASE, "agent");
            asm volatile("s_waitcnt vmcnt(0)" ::: "memory");
            const unsigned og = xb_add(&bar[XB_TOP], 1u);
            const unsigned tg = og / nx;
            if (og + 1u == (tg + 1u) * nx) xb_add(&bar[XB_TOPGEN], 1u);
            else XB_SPIN(xb_ld(&bar[XB_TOPGEN]) == tg, bar);
            __builtin_amdgcn_fence(__ATOMIC_ACQUIRE, "agent");
            xb_add(&bar[XB_XGEN(b.x)], 1u);
            asm volatile("s_waitcnt vmcnt(0)" ::: "memory");
        } else {
            XB_SPIN(xb_ld(&bar[XB_XGEN(b.x)]) == gen, bar);
            __builtin_amdgcn_fence(__ATOMIC_ACQUIRE, "agent");
            asm volatile("s_waitcnt vmcnt(0)" ::: "memory");
        }
    }
    __syncthreads();
}
namespace pg8 {
#define PG8_LAS __attribute__((address_space(3)))
typedef unsigned short bf16_t;
typedef short bf16x8 __attribute__((ext_vector_type(8)));
typedef float f32x4 __attribute__((ext_vector_type(4)));
typedef unsigned u32x4 __attribute__((ext_vector_type(4)));
constexpr int BM = 256, BK = 64, HALF = 128, HTB = HALF * BK * 2  , STAGE_BYTES = 8 * HTB, NXCD = 8, WGM = 8;

__host__ __device__ __forceinline__ int lds_byte(int r, int c) { const int st = (r >> 4) * 2 + (c >> 5), rr = r & 15, cc = c & 31, ob = rr * 64 + cc * 2; return st * 1024 + (ob ^ (((ob >> 9) & 1) << 5)); }
__host__ __device__ __forceinline__ void stage_rc(int b, int& R, int& C) { const int st = b / 1024, sb = b % 1024, swz = sb ^ (((sb >> 9) & 1) << 5); R = (st >> 1) * 16 + swz / 64; C = (st & 1) * 32 + (swz % 64) / 2; }
__host__ __device__ __forceinline__ int perm32(int rho) { const int n = rho >> 4, i = rho & 15; return 8 * (i >> 2) + 4 * n + (i & 3); }

struct Unit { int pm, pn; };
struct Gemm { const bf16_t* A; const bf16_t* Bt; int M, N, K; };

struct StaticOrder {
    int nM, nN, nwg, G, c;
    __host__ __device__ void init(int M, int N, int G_, int c_) { nM = M / BM; nN = N / BM; nwg = nM * nN; G = G_; c = c_; }
    __host__ __device__ bool next(int i, Unit& u) const {
        const long L = (long)i * G + c; if (L >= nwg) return false;
        int wgid = (int)L; { const int q = nwg / NXCD, r = nwg % NXCD, xcd = wgid % NXCD, off = wgid / NXCD; wgid = (xcd < r ? xcd * (q + 1) : r * (q + 1) + (xcd - r) * q) + off; }
        const int nig = WGM * nN, gid = wgid / nig, fm = gid * WGM, gsz = (nM - fm) < WGM ? (nM - fm) : WGM;
        u.pm = fm + ((wgid % nig) % gsz); u.pn = (wgid % nig) / gsz; return true;
    }
    __device__ __forceinline__ void a_ready(const Unit&) const {}
    __device__ __forceinline__ void done(const Unit&) const {}
};

__device__ __forceinline__ unsigned cvt_pk_bf16(float lo, float hi) { unsigned r; asm volatile("v_cvt_pk_bf16_f32 %0, %1, %2" : "=v"(r) : "v"(lo), "v"(hi)); return r; }
typedef float f32x2 __attribute__((ext_vector_type(2)));
#define PG8_GAS __attribute__((address_space(1)))
typedef unsigned u32x2 __attribute__((ext_vector_type(2)));
__device__ __forceinline__ u32x4 pack8(f32x4 v0, f32x4 v1, float sc) {
    u32x4 w; w.x = cvt_pk_bf16(v0[0] * sc, v0[1] * sc); w.y = cvt_pk_bf16(v0[2] * sc, v0[3] * sc); w.z = cvt_pk_bf16(v1[0] * sc, v1[1] * sc); w.w = cvt_pk_bf16(v1[2] * sc, v1[3] * sc); return w; }
__device__ __forceinline__ f32x4 shx4(f32x4 v, int mask) { f32x4 r; r[0] = __shfl_xor(v[0], mask); r[1] = __shfl_xor(v[1], mask); r[2] = __shfl_xor(v[2], mask); r[3] = __shfl_xor(v[3], mask); return r; }

struct EpiF32 {
    static constexpr bool PERM = false, AFTER_DRAIN = false;
    float* out; int ldc;
    __device__ __forceinline__ void operator()(const f32x4 (&acc)[2][2][4][2], const Unit& u, int wr, int wc, int fr, int fq) const {
        const int row0 = u.pm * BM + wr * 64 + fr, col0 = u.pn * BM + wc * 32 + 4 * fq;
#pragma unroll
        for (int ai = 0; ai < 2; ++ai)
#pragma unroll
            for (int m = 0; m < 4; ++m) { float* rowp = out + (size_t)(row0 + ai * HALF + m * 16) * ldc + col0;
#pragma unroll
                for (int bj = 0; bj < 2; ++bj)
#pragma unroll
                    for (int n = 0; n < 2; ++n) *(PG8_GAS f32x4*)(rowp + bj * HALF + n * 16) = acc[ai][bj][m][n]; }
    }
};
struct EpiBf16P {
    static constexpr bool PERM = true, AFTER_DRAIN = false;
    bf16_t* out; int ldc;
    __device__ __forceinline__ void operator()(const f32x4 (&acc)[2][2][4][2], const Unit& u, int wr, int wc, int fr, int fq) const {
        const int row0 = u.pm * BM + wr * 64 + fr, col0 = u.pn * BM + wc * 32 + 8 * fq;
#pragma unroll
        for (int ai = 0; ai < 2; ++ai)
#pragma unroll
            for (int m = 0; m < 4; ++m) { bf16_t* rowp = out + (size_t)(row0 + ai * HALF + m * 16) * ldc + col0;
#pragma unroll
                for (int bj = 0; bj < 2; ++bj) *(PG8_GAS u32x4*)(rowp + bj * HALF) = pack8(acc[ai][bj][m][0], acc[ai][bj][m][1], 1.0f); }
    }
};
__device__ __forceinline__ float silu_mul(float g, float uu) { return g * uu * __builtin_amdgcn_rcpf(1.0f + __builtin_amdgcn_exp2f(-1.4426950408889634f * g)); }
struct EpiSwi {
    static constexpr bool PERM = true, AFTER_DRAIN = false;
    bf16_t* out; int ldc;
    __device__ __forceinline__ void operator()(const f32x4 (&acc)[2][2][4][2], const Unit& u, int wr, int wc, int fr, int fq) const {
        const int row0 = u.pm * BM + wr * 64 + fr, col0 = u.pn * HALF + wc * 32 + 8 * fq;
#pragma unroll
        for (int ai = 0; ai < 2; ++ai)
#pragma unroll
            for (int m = 0; m < 4; ++m) {
                const f32x4 g0 = acc[ai][0][m][0], g1 = acc[ai][0][m][1], u0 = acc[ai][1][m][0], u1 = acc[ai][1][m][1];
                f32x4 a, b;
#pragma unroll
                for (int e = 0; e < 4; ++e) { a[e] = silu_mul(g0[e], u0[e]); b[e] = silu_mul(g1[e], u1[e]); }
                *(PG8_GAS u32x4*)(out + (size_t)(row0 + ai * HALF + m * 16) * ldc + col0) = pack8(a, b, 1.0f);
            }
    }
};
struct EpiProj {
    static constexpr bool PERM = true, AFTER_DRAIN = false;
    bf16_t *Qd, *Kd, *Vd, *Qs, *Ks, *Vs, *Qi, *Ki; float* Wi; const float* rope; unsigned char *Ks8, *Vs8;
    __device__ __forceinline__ void operator()(const f32x4 (&acc)[2][2][4][2], const Unit& u, int wr, int wc, int fr, int fq) const {
        const int pn = u.pn;
        const int row0 = u.pm * BM + wr * 64 + fr;
        bf16_t* base[2]; int pitch, colh[2], kind[2], ncol; float sc = 1.0f;
        if (pn < 4)       { base[0] = base[1] = Qd; pitch = 1024; colh[0] = pn * 256; colh[1] = colh[0] + 128; kind[0] = kind[1] = 1; sc = C2D; ncol = 128; }
        else if (pn < 8)  { base[0] = base[1] = Kd; pitch = 1024; colh[0] = (pn - 4) * 256; colh[1] = colh[0] + 128; kind[0] = kind[1] = 1; ncol = 128; }
        else if (pn < 12) { base[0] = base[1] = Vd; pitch = 1024; colh[0] = (pn - 8) * 256; colh[1] = colh[0] + 128; kind[0] = kind[1] = 0; ncol = 128; }
        else if (pn < 16) { base[0] = base[1] = Qs; pitch = 1024; colh[0] = (pn - 12) * 256; colh[1] = colh[0] + 128; kind[0] = kind[1] = 2; sc = C2S; ncol = 128; }
        else if (pn == 16){ base[0] = Ks; base[1] = Vs; pitch = 128; colh[0] = colh[1] = 0; kind[0] = 2; kind[1] = 0; ncol = 128; }
        else if (pn < 21) { base[0] = base[1] = Qi; pitch = 1024; colh[0] = (pn - 17) * 256; colh[1] = colh[0] + 128; kind[0] = kind[1] = 1; ncol = 128; }
        else              { base[0] = Ki; base[1] = nullptr; pitch = 64; colh[0] = colh[1] = 0; kind[0] = 1; kind[1] = 0; ncol = 64; }
        const int cl = wc * 32 + 8 * fq;
        const bool do16 = ((wc & 1) == 0) && (wc * 32 < ncol), do32 = (wc == 0);
#pragma unroll
        for (int ai = 0; ai < 2; ++ai)
#pragma unroll
            for (int m = 0; m < 4; ++m) {
                const int row = row0 + ai * HALF + m * 16;
                const float* rp = rope + (size_t)row * 48;
#pragma unroll
                for (int bj = 0; bj < 2; ++bj) {
                    f32x4 v0 = acc[ai][bj][m][0], v1 = acc[ai][bj][m][1];
                    if (kind[bj] == 1 && do16) {
                        const f32x4 p0 = shx4(v0, 16), p1 = shx4(v1, 16);
                        if (fq < 2) {
                            const f32x4 c0 = *(const PG8_GAS f32x4*)(rp), c1 = *(const PG8_GAS f32x4*)(rp + 4), s0 = *(const PG8_GAS f32x4*)(rp + 8), s1 = *(const PG8_GAS f32x4*)(rp + 12);
                            const float sg = fq == 0 ? -1.0f : 1.0f;
                            v0 = v0 * c0 + sg * (p0 * s0); v1 = v1 * c1 + sg * (p1 * s1);
                        }
                    } else if (kind[bj] == 2 && do32) {
                        const f32x4 p0 = shx4(v0, 32), p1 = shx4(v1, 32);
                        const int io = 8 * (fq & 1);
                        const f32x4 c0 = *(const PG8_GAS f32x4*)(rp + 16 + io), c1 = *(const PG8_GAS f32x4*)(rp + 20 + io), s0 = *(const PG8_GAS f32x4*)(rp + 32 + io), s1 = *(const PG8_GAS f32x4*)(rp + 36 + io);
                        const float sg = fq < 2 ? -1.0f : 1.0f;
                        v0 = v0 * c0 + sg * (p0 * s0); v1 = v1 * c1 + sg * (p1 * s1);
                    }
                    if (base[bj] != nullptr && cl < ncol) *(PG8_GAS u32x4*)(base[bj] + (size_t)row * pitch + colh[bj] + cl) = pack8(v0, v1, sc);
                    if (pn == 16) {
                        int lo = __builtin_amdgcn_cvt_pk_fp8_f32(v0[0], v0[1], 0, false); lo = __builtin_amdgcn_cvt_pk_fp8_f32(v0[2], v0[3], lo, true);
                        int hi = __builtin_amdgcn_cvt_pk_fp8_f32(v1[0], v1[1], 0, false); hi = __builtin_amdgcn_cvt_pk_fp8_f32(v1[2], v1[3], hi, true);
                        u32x2 w8; w8.x = (unsigned)lo; w8.y = (unsigned)hi;
                        *(PG8_GAS u32x2*)((bj ? Vs8 : Ks8) + (size_t)row * 128 + cl) = w8;
                    }
                    if (pn == 21 && bj == 0 && wc == 2 && fq < 2) { float* wp = Wi + (size_t)row * 16 + 8 * fq; *(PG8_GAS f32x4*)wp = v0 * IDXW_SCALE; *(PG8_GAS f32x4*)(wp + 4) = v1 * IDXW_SCALE; }
                }
            }
    }
};
template <class Epi, class Sched, bool ALIGN_EPI = false, bool SP2 = false>
__device__ __forceinline__ void gemm_phase(PG8_LAS unsigned char* lds, const Gemm g, const Sched& S, const Epi& E) {
    const int tid = threadIdx.x, wid = __builtin_amdgcn_readfirstlane(tid >> 6), lane = tid & 63, wr = wid >> 2, wc = wid & 3, fr = lane & 15, fq = lane >> 4;
    const int K = g.K, nt = K / BK;
    unsigned voffA[2], voffB[2];
#pragma unroll
    for (int i = 0; i < 2; ++i) { int R, C; stage_rc(tid * 16 + i * 8192, R, C); const int Rb = Epi::PERM ? ((R & ~31) + perm32(R & 31)) : R;
        voffA[i] = (unsigned)(R * K + C) * 2u; voffB[i] = (unsigned)(Rb * K + C) * 2u; }
    const size_t kstep = (size_t)(BK * 2);
    const size_t hstep = (size_t)HALF * K * 2;
    const size_t tstep = 2 * hstep;
    const unsigned ldsw = (unsigned)wid * 1024u;
    const int aoff = lds_byte(wr * 64 + fr, fq * 8), boff = lds_byte(wc * 32 + fr, fq * 8);
#define PG8_SA(b, h) (((b) * 2 + (h)) * HTB)
#define PG8_SB(b, h) ((4 + (b) * 2 + (h)) * HTB)
#define PG8_STAGE(bufoff, gbase, voff) do { _Pragma("unroll") for (int _i = 0; _i < 2; ++_i) \
        __builtin_amdgcn_global_load_lds((const unsigned*)((const char*)(gbase) + (voff)[_i]), (PG8_LAS unsigned*)(lds + (bufoff) + ldsw + _i * 8192), 16, 0, 0); } while (0)
#define PG8_LDA(dst, b, h) do { _Pragma("unroll") for (int m = 0; m < 4; ++m) _Pragma("unroll") for (int k = 0; k < 2; ++k) dst[m][k] = *(const PG8_LAS bf16x8*)(lds + PG8_SA(b, h) + aoff + m * 2048 + k * 1024); } while (0)
#define PG8_LDB(dst, b, h) do { _Pragma("unroll") for (int n = 0; n < 2; ++n) _Pragma("unroll") for (int k = 0; k < 2; ++k) dst[n][k] = *(const PG8_LAS bf16x8*)(lds + PG8_SB(b, h) + boff + n * 2048 + k * 1024); } while (0)
#define PG8_MMA(ai, bj, At, Bt) do { __builtin_amdgcn_s_setprio(1); _Pragma("unroll") for (int m = 0; m < 4; ++m) _Pragma("unroll") for (int n = 0; n < 2; ++n) _Pragma("unroll") for (int k = 0; k < 2; ++k) \
        acc[ai][bj][m][n] = __builtin_amdgcn_mfma_f32_16x16x32_bf16(Bt[n][k], At[m][k], acc[ai][bj][m][n], 0, 0, 0); __builtin_amdgcn_s_setprio(0); } while (0)
#define PG8_WAIT_V(n) asm volatile("s_waitcnt vmcnt(" #n ")" ::: "memory")
#define PG8_WAIT_L(n) asm volatile("s_waitcnt lgkmcnt(" #n ")" ::: "memory")
#define PG8_BAR __builtin_amdgcn_s_barrier()
#define PG8_SCHED __builtin_amdgcn_sched_barrier(0)
    Unit cur, nxt; int ui = 0;
    if (!S.next(0, cur)) return;
    f32x4 acc[2][2][4][2];
#pragma unroll
    for (int a = 0; a < 2; ++a)
#pragma unroll
        for (int b = 0; b < 2; ++b)
#pragma unroll
            for (int m = 0; m < 4; ++m)
#pragma unroll
                for (int n = 0; n < 2; ++n) acc[a][b][m][n] = (f32x4){0.f, 0.f, 0.f, 0.f};
    bf16x8 At[4][2], B0[2][2], B1[2][2];
    const char* cA = (const char*)g.A + (size_t)cur.pm * tstep; const char* cB = (const char*)g.Bt + (size_t)cur.pn * tstep;
    S.a_ready(cur);
    if constexpr (SP2) {
        PG8_STAGE(PG8_SB(0, 0), cB, voffB); PG8_STAGE(PG8_SB(0, 1), cB + hstep, voffB); PG8_STAGE(PG8_SA(0, 0), cA, voffA); PG8_STAGE(PG8_SA(0, 1), cA + hstep, voffA);
        if (wr == 1) PG8_BAR;
        PG8_WAIT_V(2); PG8_BAR;
        PG8_STAGE(PG8_SB(1, 0), cB + kstep, voffB); PG8_STAGE(PG8_SA(1, 0), cA + kstep, voffA); PG8_STAGE(PG8_SB(1, 1), cB + hstep + kstep, voffB);
        PG8_WAIT_V(6); PG8_BAR;
    } else {
        PG8_STAGE(PG8_SB(0, 0), cB, voffB); PG8_STAGE(PG8_SA(0, 0), cA, voffA); PG8_STAGE(PG8_SB(0, 1), cB + hstep, voffB); PG8_STAGE(PG8_SA(0, 1), cA + hstep, voffA);
        if (wr == 1) PG8_BAR;
        PG8_WAIT_V(4); PG8_BAR;
        PG8_STAGE(PG8_SB(1, 0), cB + kstep, voffB); PG8_STAGE(PG8_SA(1, 0), cA + kstep, voffA); PG8_STAGE(PG8_SB(1, 1), cB + hstep + kstep, voffB);
        PG8_WAIT_V(6); PG8_BAR;
    }
    for (;;) {
        const bool has_next = S.next(ui + 1, nxt);
        const char* nA = has_next ? (const char*)g.A + (size_t)nxt.pm * tstep : cA; const char* nB = has_next ? (const char*)g.Bt + (size_t)nxt.pn * tstep : cB;
        for (int t = 0; t < nt; t += 2) {
            const bool last = (t == nt - 2);
            const char* a1 = cA + (size_t)(t + 1) * kstep;
            const char* a2 = last ? nA : cA + (size_t)(t + 2) * kstep; const char* b2 = last ? nB : cB + (size_t)(t + 2) * kstep;
            const char* a3 = a2 + kstep; const char* b3 = b2 + kstep;
            if (last && has_next) S.a_ready(nxt);
            if constexpr (SP2) {
            PG8_LDB(B0, 0, 0); PG8_LDB(B1, 0, 1); PG8_SCHED; PG8_LDA(At, 0, 0); PG8_STAGE(PG8_SA(1, 1), a1 + hstep, voffA);
            PG8_WAIT_V(8); PG8_WAIT_L(0); PG8_BAR; PG8_MMA(0, 0, At, B0); PG8_MMA(0, 1, At, B1); PG8_BAR; PG8_SCHED;
            PG8_LDA(At, 0, 1); PG8_STAGE(PG8_SB(0, 0), b2, voffB); PG8_STAGE(PG8_SB(0, 1), b2 + hstep, voffB); PG8_STAGE(PG8_SA(0, 0), a2, voffA);
            PG8_WAIT_V(8); PG8_WAIT_L(0); PG8_BAR; PG8_MMA(1, 0, At, B0); PG8_MMA(1, 1, At, B1); PG8_BAR; PG8_SCHED;
            PG8_LDB(B0, 1, 0); PG8_LDB(B1, 1, 1); PG8_SCHED; PG8_LDA(At, 1, 0); PG8_STAGE(PG8_SA(0, 1), a2 + hstep, voffA);
            PG8_WAIT_V(8); PG8_WAIT_L(0); PG8_BAR; PG8_MMA(0, 0, At, B0); PG8_MMA(0, 1, At, B1); PG8_BAR; PG8_SCHED;
            PG8_LDA(At, 1, 1); PG8_STAGE(PG8_SB(1, 0), b3, voffB); PG8_STAGE(PG8_SB(1, 1), b3 + hstep, voffB); PG8_STAGE(PG8_SA(1, 0), a3, voffA);
            PG8_WAIT_V(8); PG8_WAIT_L(0); PG8_BAR; PG8_MMA(1, 0, At, B0); PG8_MMA(1, 1, At, B1); PG8_BAR; PG8_SCHED;
            } else {
            PG8_LDB(B0, 0, 0); PG8_SCHED; PG8_LDA(At, 0, 0); PG8_STAGE(PG8_SA(1, 1), a1 + hstep, voffA);
            PG8_WAIT_L(8); PG8_BAR; PG8_WAIT_L(0); PG8_MMA(0, 0, At, B0); PG8_BAR; PG8_SCHED;
            PG8_LDB(B1, 0, 1); PG8_STAGE(PG8_SB(0, 0), b2, voffB);
            PG8_BAR; PG8_WAIT_L(0); PG8_MMA(0, 1, At, B1); PG8_BAR;
            PG8_LDA(At, 0, 1); PG8_STAGE(PG8_SA(0, 0), a2, voffA);
            PG8_BAR; PG8_WAIT_L(0); PG8_MMA(1, 0, At, B0); PG8_BAR; PG8_SCHED;
            PG8_STAGE(PG8_SB(0, 1), b2 + hstep, voffB);
            PG8_WAIT_V(6); PG8_BAR; PG8_MMA(1, 1, At, B1); PG8_BAR;
            PG8_LDB(B0, 1, 0); PG8_SCHED; PG8_LDA(At, 1, 0); PG8_STAGE(PG8_SA(0, 1), a2 + hstep, voffA);
            PG8_WAIT_L(8); PG8_BAR; PG8_WAIT_L(0); PG8_MMA(0, 0, At, B0); PG8_BAR; PG8_SCHED;
            PG8_LDB(B1, 1, 1); PG8_STAGE(PG8_SB(1, 0), b3, voffB);
            PG8_BAR; PG8_WAIT_L(0); PG8_MMA(0, 1, At, B1); PG8_BAR;
            PG8_LDA(At, 1, 1); PG8_STAGE(PG8_SA(1, 0), a3, voffA);
            PG8_BAR; PG8_WAIT_L(0); PG8_MMA(1, 0, At, B0); PG8_BAR; PG8_SCHED;
            PG8_STAGE(PG8_SB(1, 1), b3 + hstep, voffB);
            PG8_WAIT_V(6); PG8_BAR; PG8_MMA(1, 1, At, B1); PG8_BAR;
            }
        }
        if constexpr (ALIGN_EPI) { if (wr == 0) PG8_BAR; }
        if constexpr (!Epi::AFTER_DRAIN) { E(acc, cur, wr, wc, fr, fq); S.done(cur); }
        if (!has_next) break;
#pragma unroll
        for (int a = 0; a < 2; ++a)
#pragma unroll
            for (int b = 0; b < 2; ++b)
#pragma unroll
                for (int m = 0; m < 4; ++m)
#pragma unroll
                    for (int n = 0; n < 2; ++n) acc[a][b][m][n] = (f32x4){0.f, 0.f, 0.f, 0.f};
        cur = nxt; cA = nA; cB = nB; ++ui;
        if constexpr (ALIGN_EPI) { if (wr == 1) PG8_BAR; }
    }
    PG8_WAIT_V(0);
    if constexpr (!ALIGN_EPI) { if (wr == 0) PG8_BAR; }
    PG8_BAR;
    if constexpr (Epi::AFTER_DRAIN) { E.fused(acc, cur, wr, wc, fr, fq, lds, wid, lane); S.done(cur); }
#undef PG8_SA
#undef PG8_SB
#undef PG8_STAGE
#undef PG8_LDA
#undef PG8_LDB
#undef PG8_MMA
#undef PG8_WAIT_V
#undef PG8_WAIT_L
#undef PG8_BAR
#undef PG8_SCHED
}
}
namespace attn_body {
using bf16=__hip_bfloat16;
using bf16x8=__attribute__((ext_vector_type(8)))short;
using s16x4=__attribute__((ext_vector_type(4)))short;
using f32x16=__attribute__((ext_vector_type(16)))float;
using u32x4=__attribute__((ext_vector_type(4)))unsigned;
constexpr int SEQ=4096,D=64,DM=1024;
constexpr int NW=8,QBLK=32,QB=QBLK*NW,KVBLK=64,NQB=SEQ/QB;
constexpr int ATTN_PITCH=DM, ATTN_UNIT_ROWS=QB;
__device__ __forceinline__ int crow(int r,int hi){return (r&3)+8*(r>>2)+4*hi;}
#define SBAR() __builtin_amdgcn_sched_barrier(0)
__device__ __forceinline__ void cmask(f32x16&p0,f32x16&p1,int jb,int qrel,int hi){
  const float NEG=-INFINITY; int kb=64*jb+4*hi;
  #pragma unroll
  for(int r=0;r<16;++r){int kv=kb+(r&3)+8*(r>>2); if(kv>qrel)p0[r]=NEG; if(kv+32>qrel)p1[r]=NEG;}
}

constexpr int NSLOT=3, SLOTB=8192;
constexpr int LDS_K=0, LDS_V=NSLOT*SLOTB, LDS_WS=2*NSLOT*SLOTB, LDS_OST=LDS_WS+NW*64*4, LDS_BYTES=LDS_OST+NW*4096;
constexpr float C2=0.125f*1.4426950408889634f;
__device__ __forceinline__ void glds16(const void*gsrc,unsigned lds_dst){unsigned keep;
  asm volatile("s_mov_b32 %0, m0\n\ts_mov_b32 m0, %2\n\ts_nop 0\n\tglobal_load_lds_dwordx4 %1, off\n\ts_mov_b32 m0, %0":"=&s"(keep):"v"(gsrc),"s"(lds_dst):"memory");}
__device__ __forceinline__ float max3f(float a,float b,float c){float r;asm("v_max3_f32 %0, %1, %2, %3":"=v"(r):"v"(a),"v"(b),"v"(c));return r;}
__device__ __forceinline__ float max2f(float a,float b){float r;asm("v_max_f32_e32 %0, %1, %2":"=v"(r):"v"(a),"v"(b));return r;}
__device__ __forceinline__ float fadd_s(float a,float b){float r;asm("v_add_f32_e32 %0, %1, %2":"=v"(r):"v"(a),"v"(b));return r;}
__device__ __forceinline__ float fsub_s(float a,float b){float r;asm("v_sub_f32_e32 %0, %1, %2":"=v"(r):"v"(a),"v"(b));return r;}
typedef float f32x2_t __attribute__((ext_vector_type(2))); typedef __bf16 bf16x2_t __attribute__((ext_vector_type(2)));
__device__ __forceinline__ unsigned cvtpk_s(float lo,float hi){f32x2_t v={lo,hi};bf16x2_t b=__builtin_convertvector(v,bf16x2_t);return __builtin_bit_cast(unsigned,b);}
#define WAIT_BAR(N) asm volatile("s_waitcnt vmcnt(" #N ") lgkmcnt(0)\n\ts_barrier":::"memory")

__device__ __forceinline__ void qkt(f32x16&p0,f32x16&p1,const char*Kslot,const bf16x8*qr,const f32x16&negm,int r32,int hi){
  const char*kb=Kslot+hi*1024+r32*16;
  #pragma unroll
  for(int d0=0;d0<4;++d0){
    const bf16x8 b0=*reinterpret_cast<const bf16x8*>(kb+d0*2048);
    const bf16x8 b1=*reinterpret_cast<const bf16x8*>(kb+d0*2048+512);
    if(d0==0){p0=__builtin_amdgcn_mfma_f32_32x32x16_bf16(b0,qr[0],negm,0,0,0);p1=__builtin_amdgcn_mfma_f32_32x32x16_bf16(b1,qr[0],negm,0,0,0);}
    else{p0=__builtin_amdgcn_mfma_f32_32x32x16_bf16(b0,qr[d0],p0,0,0,0);p1=__builtin_amdgcn_mfma_f32_32x32x16_bf16(b1,qr[d0],p1,0,0,0);}}
}
typedef __attribute__((address_space(3))) const char* lds_cptr;
typedef short v4i16_t __attribute__((ext_vector_type(4)));
__device__ __forceinline__ void kload8(bf16x8*kf,lds_cptr kp){
  kf[0]=*(const __attribute__((address_space(3))) bf16x8*)(kp);      kf[1]=*(const __attribute__((address_space(3))) bf16x8*)(kp+512);
  kf[2]=*(const __attribute__((address_space(3))) bf16x8*)(kp+2048); kf[3]=*(const __attribute__((address_space(3))) bf16x8*)(kp+2560);
  kf[4]=*(const __attribute__((address_space(3))) bf16x8*)(kp+4096); kf[5]=*(const __attribute__((address_space(3))) bf16x8*)(kp+4608);
  kf[6]=*(const __attribute__((address_space(3))) bf16x8*)(kp+6144); kf[7]=*(const __attribute__((address_space(3))) bf16x8*)(kp+6656);
}
__device__ __forceinline__ void kload2(bf16x8*kf,lds_cptr kp,int j){ kf[2*j]=*(const __attribute__((address_space(3))) bf16x8*)(kp+j*2048); kf[2*j+1]=*(const __attribute__((address_space(3))) bf16x8*)(kp+j*2048+512); }
__device__ __forceinline__ s16x4 vtr(lds_cptr p){ return __builtin_bit_cast(s16x4,__builtin_amdgcn_ds_read_tr16_b64_v4i16((__attribute__((address_space(3))) v4i16_t*)p)); }
__device__ __forceinline__ float rowmax(const f32x16&p0,const f32x16&p1){
  float a=max3f(p0[0],p0[1],p1[0]),b=max3f(p0[2],p0[3],p1[1]);a=max3f(a,p1[2],p1[3]);
  #pragma unroll
  for(int r=4;r<16;r+=4){a=max3f(a,p0[r],p0[r+1]);b=max3f(b,p0[r+2],p0[r+3]);a=max3f(a,p1[r],p1[r+1]);b=max3f(b,p1[r+2],p1[r+3]);}
  const float m=max2f(a,b);
  auto rr=__builtin_amdgcn_permlane32_swap(__float_as_uint(m),__float_as_uint(m),false,false);
  return max2f(__uint_as_float(rr[0]),__uint_as_float(rr[1]));
}
__device__ __forceinline__ void pv(f32x16*o,int vb,bf16x8 pa0,bf16x8 pa1,bf16x8 pa2,bf16x8 pa3){
  #pragma unroll
  for(int d0=0;d0<2;++d0){s16x4 lo[4],hi[4];
    #pragma unroll
    for(int ks=0;ks<4;++ks){
      asm volatile("ds_read_b64_tr_b16 %0,%1 offset:%c2":"=&v"(lo[ks]):"v"(vb),"i"(d0*4096+ks*1024):"memory");
      asm volatile("ds_read_b64_tr_b16 %0,%1 offset:%c2":"=&v"(hi[ks]):"v"(vb),"i"(d0*4096+ks*1024+512):"memory");}
    asm volatile("s_waitcnt lgkmcnt(0)":::"memory");SBAR();
    #define PK(k) (bf16x8){lo[k][0],lo[k][1],lo[k][2],lo[k][3],hi[k][0],hi[k][1],hi[k][2],hi[k][3]}
    o[d0]=__builtin_amdgcn_mfma_f32_32x32x16_bf16(pa0,PK(0),o[d0],0,0,0);
    o[d0]=__builtin_amdgcn_mfma_f32_32x32x16_bf16(pa1,PK(1),o[d0],0,0,0);
    o[d0]=__builtin_amdgcn_mfma_f32_32x32x16_bf16(pa2,PK(2),o[d0],0,0,0);
    o[d0]=__builtin_amdgcn_mfma_f32_32x32x16_bf16(pa3,PK(3),o[d0],0,0,0);
    #undef PK
  }
}

#ifndef ATTN_STORE16
#define ATTN_STORE16(p,v) (*(u32x4*)(p)=(v))
#endif
template<int THRL> __device__ __forceinline__ void attn_unit(int b,int qcol,int vcol,int qb,const bf16*Q,const bf16*__restrict__ K,const bf16*__restrict__ V,bf16*O,char*shm){
  const int tid=threadIdx.x,lane=tid&63,r32=lane&31,hi=lane>>5; const int wid=__builtin_amdgcn_readfirstlane(tid>>6);
  const long rowbase=(long)b*SEQ; const int q0=qb*QB;
  const bf16*Qw=Q+(rowbase+q0+wid*QBLK)*DM+qcol;
  const bf16*Kh=K+rowbase*DM+qcol,*Vh=V+rowbase*DM+vcol;
  const unsigned lds0=(unsigned)(uintptr_t)shm;
  float*wsf=(float*)(shm+LDS_WS)+wid*64;
  const bf16*ksrc=Kh+(long)lane*DM+wid*8;
  const bf16*vsrc=Vh+(long)(16*(wid&3)+(lane>>2))*DM+(wid>>2)*32+(lane&3)*8;
  const unsigned kdst=lds0+LDS_K+wid*1024, vdst=lds0+LDS_V+wid*1024;
  #define DMA_K(t,slot) glds16(ksrc+(long)(t)*KVBLK*DM,(unsigned)__builtin_amdgcn_readfirstlane(kdst+(slot)))
  #define DMA_V(t,slot) glds16(vsrc+(long)(t)*KVBLK*DM,(unsigned)__builtin_amdgcn_readfirstlane(vdst+(slot)))
  const int vb0=(int)(lds0+LDS_V)+((lane>>4)&1)*32+(lane&3)*8+(4*hi+((lane&15)>>2))*64;
  const char*Kbase=shm+LDS_K; bf16x8 kf[8];
  const lds_cptr shm3=(lds_cptr)shm; const lds_cptr kp0=shm3+LDS_K+hi*1024+r32*16; const lds_cptr vp0=shm3+LDS_V+((lane>>4)&1)*32+(lane&3)*8+(4*hi+((lane&15)>>2))*64;
  const int NT=(q0+QB)/KVBLK;
  DMA_K(0,0);DMA_V(0,0);DMA_K(1,SLOTB);
  bf16x8 qr[4];
  #pragma unroll
  for(int d0=0;d0<4;++d0)qr[d0]=*reinterpret_cast<const bf16x8*>(&Qw[(long)r32*DM+d0*16+hi*8]);
  float mhat=0.f,l_reg=0.f;f32x16 o[2];o[0]=f32x16{};o[1]=f32x16{};f32x16 negm=f32x16{};asm volatile("":"+v"(negm));
  const int qrel=wid*QBLK+r32;
  #define CMASK(P0,P1,t) do{int jb_=(t)-(NT-4); if(jb_>=0)cmask(P0,P1,jb_,qrel,hi);}while(0)
  bool resc=false;
  #define START(P0,P1) do{ const float rm=rowmax(P0,P1); resc=false; \
    { const float dl=rm; mhat=fadd_s(mhat,dl); \
      _Pragma("unroll") for(int r=0;r<16;++r){P0[r]=fsub_s(P0[r],dl);P1[r]=fsub_s(P1[r],dl);} \
      _Pragma("unroll") for(int r=0;r<16;++r)negm[r]=-mhat; asm volatile("":"+v"(negm)); } \
    _Pragma("unroll") for(int r=0;r<16;++r)P0[r]=__builtin_amdgcn_exp2f(P0[r]); }while(0)
  #define RESC() do{ if(resc){ asm volatile("s_waitcnt lgkmcnt(0)":::"memory"); \
      _Pragma("unroll") for(int d_=0;d_<2;++d_) _Pragma("unroll") for(int r=0;r<16;++r)o[d_][r]*=wsf[crow(r,hi)]; } }while(0)
  f32x16 pA0,pA1,pB0,pB1;
  int sl_prev=0,sl_cur=0,sl_next=SLOTB;
  #define ROT() do{sl_prev=sl_cur;sl_cur=sl_next;sl_next=(sl_next==(NSLOT-1)*SLOTB)?0:sl_next+SLOTB;}while(0)
  DMA_K(2,2*SLOTB);
  WAIT_BAR(3);
  qkt(pA0,pA1,Kbase,qr,negm,r32,hi);asm volatile("s_nop 15\n\ts_nop 7":"+v"(pA0),"+v"(pA1));CMASK(pA0,pA1,0);
  START(pA0,pA1);
  _Pragma("unroll") for(int r=0;r<16;++r)pA1[r]=__builtin_amdgcn_exp2f(pA1[r]);
  WAIT_BAR(0);
  DMA_K(3,0);DMA_V(1,SLOTB);
  ROT();
  kload8(kf,kp0+sl_cur);
  WAIT_BAR(2);
  s16x4 vlo[8],vhi[8]; u32x4 pw0,pw1,pw2,pw3;
  #define PKW(P,B) cvtpk_s(P[B],P[B+1])
  #define PAF(k) __builtin_bit_cast(bf16x8,pw##k)
  #define VFR(i) (bf16x8){vlo[i][0],vlo[i][1],vlo[i][2],vlo[i][3],vhi[i][0],vhi[i][1],vhi[i][2],vhi[i][3]}
  #define PIN(x) asm volatile("":"+v"(x))
  #define MX3(a,b,c) __builtin_fmaxf(__builtin_fmaxf((a),(b)),(c))
  #define GAPA(MF,A0,A1,A2,A3,W0,W1,PW) do{ MF; sacc+=A0; sacc+=A1; sacc+=A2; sacc+=A3; PIN(sacc); W0; W1; PIN(PW); SBAR(); }while(0)
  #define EX(v) __builtin_amdgcn_exp2f(v)
  #define GAPB(MF,X,B) do{ MF; X[B]=EX(X[B]); X[B+1]=EX(X[B+1]); X[B+2]=EX(X[B+2]); X[B+3]=EX(X[B+3]); PIN(X); SBAR(); }while(0)
  #define VRD(i) do{ vlo[i]=vtr(vp_+(((i)>>2)*4096+((i)&3)*1024)); vhi[i]=vtr(vp_+(((i)>>2)*4096+((i)&3)*1024+512)); }while(0)
  #define KRD(G,j) do{ if(G){ kload2(kf,kp0+sl_next,j); SBAR(); } }while(0)
  #define STEP(C0,C1,P0,P1,t,GK,GV,GL) do{ SBAR(); \
    const lds_cptr vp_=vp0+sl_prev; \
    VRD(0); SBAR(); float sacc=(P0[0]+P0[1]); \
    GAPA(C0=__builtin_amdgcn_mfma_f32_32x32x16_bf16(kf[0],qr[0],negm,0,0,0), P0[2],P0[3],P0[4],P0[5],     pw0[0]=PKW(P0,0), pw0[1]=PKW(P0,2), pw0); \
    VRD(4); SBAR(); GAPA(C1=__builtin_amdgcn_mfma_f32_32x32x16_bf16(kf[1],qr[0],negm,0,0,0), P0[6],P0[7],P0[8],P0[9],     pw0[2]=PKW(P0,4), pw0[3]=PKW(P0,6), pw0); \
    VRD(1); SBAR(); GAPA(C0=__builtin_amdgcn_mfma_f32_32x32x16_bf16(kf[2],qr[1],C0,0,0,0),   P0[10],P0[11],P0[12],P0[13], pw1[0]=PKW(P0,8), pw1[1]=PKW(P0,10), pw1); \
    VRD(5); SBAR(); GAPA(C1=__builtin_amdgcn_mfma_f32_32x32x16_bf16(kf[3],qr[1],C1,0,0,0),   P0[14],P0[15],P1[0],P1[1],   pw1[2]=PKW(P0,12),pw1[3]=PKW(P0,14), pw1); \
    VRD(2); SBAR(); GAPA(C0=__builtin_amdgcn_mfma_f32_32x32x16_bf16(kf[4],qr[2],C0,0,0,0),   P1[2],P1[3],P1[4],P1[5],     pw2[0]=PKW(P1,0), pw2[1]=PKW(P1,2), pw2); \
    VRD(6); SBAR(); GAPA(C1=__builtin_amdgcn_mfma_f32_32x32x16_bf16(kf[5],qr[2],C1,0,0,0),   P1[6],P1[7],P1[8],P1[9],     pw2[2]=PKW(P1,4), pw2[3]=PKW(P1,6), pw2); \
    VRD(3); SBAR(); GAPA(C0=__builtin_amdgcn_mfma_f32_32x32x16_bf16(kf[6],qr[3],C0,0,0,0),   P1[10],P1[11],P1[12],P1[13], pw3[0]=PKW(P1,8), pw3[1]=PKW(P1,10), pw3); \
    VRD(7); SBAR(); GAPA(C1=__builtin_amdgcn_mfma_f32_32x32x16_bf16(kf[7],qr[3],C1,0,0,0),   P1[14],P1[15],0.f,0.f,       pw3[2]=PKW(P1,12),pw3[3]=PKW(P1,14), pw3); \
    l_reg+=sacc; \
    if(GK){DMA_K((t)+3,sl_cur);} if(GV){DMA_V((t)+1,sl_next);} \
    CMASK(C0,C1,t); \
    { float a=MX3(C0[0],C0[1],C1[0]),b=MX3(C0[2],C0[3],C1[1]); a=MX3(a,C1[2],C1[3]); \
      _Pragma("unroll") for(int r=4;r<16;r+=4){a=MX3(a,C0[r],C0[r+1]);b=MX3(b,C0[r+2],C0[r+3]);a=MX3(a,C1[r],C1[r+1]);b=MX3(b,C1[r+2],C1[r+3]);} \
      float rm=__builtin_fmaxf(a,b); { auto rr=__builtin_amdgcn_permlane32_swap(__float_as_uint(rm),__float_as_uint(rm),false,false); rm=__builtin_fmaxf(__uint_as_float(rr[0]),__uint_as_float(rr[1])); } \
      resc=false; \
      if(__builtin_expect(__any(rm>(float)THRL),0)){ const float dl=__builtin_fmaxf(rm,0.f); mhat+=dl; \
        _Pragma("unroll") for(int r=0;r<16;++r){C0[r]-=dl;C1[r]-=dl;} \
        _Pragma("unroll") for(int r=0;r<16;++r)negm[r]=-mhat; asm volatile("":"+v"(negm)); \
        const float f=__builtin_amdgcn_exp2f(-dl); l_reg*=f; if(hi==0)wsf[r32]=f; resc=true; } } \
    SBAR(); \
    GAPB(o[0]=__builtin_amdgcn_mfma_f32_32x32x16_bf16(PAF(0),VFR(0),o[0],0,0,0), C0,0); \
    GAPB(o[1]=__builtin_amdgcn_mfma_f32_32x32x16_bf16(PAF(0),VFR(4),o[1],0,0,0), C0,4); \
    KRD(GL,0); GAPB(o[0]=__builtin_amdgcn_mfma_f32_32x32x16_bf16(PAF(1),VFR(1),o[0],0,0,0), C0,8); \
    KRD(GL,1); GAPB(o[1]=__builtin_amdgcn_mfma_f32_32x32x16_bf16(PAF(1),VFR(5),o[1],0,0,0), C0,12); \
    KRD(GL,2); GAPB(o[0]=__builtin_amdgcn_mfma_f32_32x32x16_bf16(PAF(2),VFR(2),o[0],0,0,0), C1,0); \
    KRD(GL,3); GAPB(o[1]=__builtin_amdgcn_mfma_f32_32x32x16_bf16(PAF(2),VFR(6),o[1],0,0,0), C1,4); \
    GAPB(o[0]=__builtin_amdgcn_mfma_f32_32x32x16_bf16(PAF(3),VFR(3),o[0],0,0,0), C1,8); \
    GAPB(o[1]=__builtin_amdgcn_mfma_f32_32x32x16_bf16(PAF(3),VFR(7),o[1],0,0,0), C1,12); \
    }while(0)
  int t=1;
  #undef CMASK
  #define CMASK(P0,P1,t) do{}while(0)
  for(;t+5<NT;t+=2){
    STEP(pB0,pB1,pA0,pA1,t,true,true,true);     WAIT_BAR(2); RESC(); ROT();
    STEP(pA0,pA1,pB0,pB1,t+1,true,true,true);   WAIT_BAR(2); RESC(); ROT();
  }
  #undef CMASK
  #define CMASK(P0,P1,t) do{int jb_=(t)-(NT-4); if(jb_>=0)cmask(P0,P1,jb_,qrel,hi);}while(0)
  #define ENDW(tt) do{ if((tt)+3<NT){WAIT_BAR(2);} else if((tt)+2<NT){WAIT_BAR(1);} else {WAIT_BAR(0);} }while(0)
  for(;t+1<NT;t+=2){
    STEP(pB0,pB1,pA0,pA1,t,(t+3<NT),(t+1<NT),(t+1<NT));       ENDW(t);   RESC(); ROT();
    STEP(pA0,pA1,pB0,pB1,t+1,(t+4<NT),(t+2<NT),(t+2<NT));     ENDW(t+1); RESC(); ROT();
  }
  STEP(pB0,pB1,pA0,pA1,NT-1,false,false,false); RESC();
  { float sacc=pB0[0]+pB0[1]; _Pragma("unroll") for(int r=2;r<16;++r)sacc+=pB0[r]; _Pragma("unroll") for(int r=0;r<16;++r)sacc+=pB1[r]; l_reg+=sacc;
    pw0=(u32x4){PKW(pB0,0),PKW(pB0,2),PKW(pB0,4),PKW(pB0,6)};pw1=(u32x4){PKW(pB0,8),PKW(pB0,10),PKW(pB0,12),PKW(pB0,14)};pw2=(u32x4){PKW(pB1,0),PKW(pB1,2),PKW(pB1,4),PKW(pB1,6)};pw3=(u32x4){PKW(pB1,8),PKW(pB1,10),PKW(pB1,12),PKW(pB1,14)};
    SBAR(); pv(o,vb0+sl_cur,PAF(0),PAF(1),PAF(2),PAF(3)); }
  #undef PKW
  #undef PAF
  #undef VFR
  #undef PIN
  #undef MX3
  #undef GAPA
  #undef GAPB
  #undef EX
  #undef VRD
  #undef KRD
  #undef STEP
  #undef ENDW
  {auto rr=__builtin_amdgcn_permlane32_swap(__float_as_uint(l_reg),__float_as_uint(l_reg),false,false);l_reg=__uint_as_float(rr[0])+__uint_as_float(rr[1]);}
  if(hi==0)wsf[32+r32]=l_reg;asm volatile("s_waitcnt lgkmcnt(0)":::"memory");
  float rli[16];
  #pragma unroll
  for(int r=0;r<16;++r)rli[r]=__builtin_amdgcn_rcpf(wsf[32+crow(r,hi)]);
  bf16*Ow=O+(rowbase+q0+wid*QBLK)*DM+vcol;
  { bf16*stg=(bf16*)(shm+LDS_OST)+wid*2048;
    #pragma unroll
    for(int r=0;r<16;++r){const int orow=crow(r,hi);
      #pragma unroll
      for(int d0=0;d0<2;++d0)stg[orow*64+d0*32+r32]=__float2bfloat16(o[d0][r]*rli[r]);}
    asm volatile("s_waitcnt lgkmcnt(0)":::"memory");
    #pragma unroll
    for(int i=0;i<4;++i){const int row=i*8+(lane>>3),ch=lane&7; const u32x4 v=*(const u32x4*)(stg+row*64+ch*8); ATTN_STORE16(Ow+(long)row*DM+ch*8,v);} }
  asm volatile("s_waitcnt lgkmcnt(0)\n\ts_barrier":::"memory");
  #undef DMA_K
  #undef DMA_V
  #undef CMASK
  #undef START
  #undef RESC
  #undef ROT
}
constexpr int ATTN_LDS_BYTES=LDS_BYTES;
struct AttnTensors { const bf16* Q; const bf16* K; const bf16* V; bf16* O1; bf16* O2; };
struct AttnUnit { int bh; int qb; };
struct StaticOrder {
  int vcu, G;
  __device__ __forceinline__ explicit StaticOrder(int grid,int vcu_):vcu(vcu_),G(grid){}
  __device__ __forceinline__ bool next(int i,AttnUnit&u)const{
    if(G==256){ if(i>=4)return false; const int s=vcu&3; u.bh=vcu>>2; u.qb=(i==0)?s:(i==1)?7-s:(i==2)?8+s:15-s; return true; }
    const int L=vcu+i*G; if(L>=1024)return false; u.bh=L>>4; u.qb=15-(L&15); return true; }
  __device__ __forceinline__ void a_ready(const AttnUnit&)const{}
  __device__ __forceinline__ void done(const AttnUnit&)const{}
};
template<class Sched,int THRL=8> __device__ __forceinline__ void attn_phase(char*lds,const AttnTensors&T,const Sched&S){
  AttnUnit u;
  for(int i=0;S.next(i,u);++i){ S.a_ready(u); const int b=u.bh>>5,rem=u.bh&31,h=rem>>2,map=(rem>>1)&1,vh=rem&1;
    attn_unit<THRL>(b,h*128+map*64,h*128+vh*64,u.qb,T.Q,T.K,T.V,map?T.O2:T.O1,lds); S.done(u); }
}
#undef SBAR
#undef WAIT_BAR
}
namespace dsa_body {
typedef short bf16x8 __attribute__((ext_vector_type(8)));
typedef short s16x4 __attribute__((ext_vector_type(4)));
typedef float f32x4 __attribute__((ext_vector_type(4)));
typedef float f32x16 __attribute__((ext_vector_type(16)));
typedef unsigned u32x4 __attribute__((ext_vector_type(4)));
typedef unsigned short bf16;
#define DL __attribute__((address_space(3)))
#define DG __attribute__((address_space(1)))
constexpr int SEQ = 4096;
constexpr int L_KBUF = 0, L_HIST = 65536, L_SEL = L_HIST + 16 * 4096, L_TOTAL = L_SEL + 8 * 1280;
constexpr int CAND_CAP = 1024;

__device__ __forceinline__ unsigned ordkey(float x) { const unsigned u = __float_as_uint(x); return u ^ ((unsigned)((int)u >> 31) | 0x80000000u); }
__device__ __forceinline__ unsigned mbcnt64(unsigned long long m) { return __builtin_amdgcn_mbcnt_hi((unsigned)(m >> 32), __builtin_amdgcn_mbcnt_lo((unsigned)m, 0u)); }
__device__ __forceinline__ void wg_barrier() { asm volatile("s_waitcnt vmcnt(0) lgkmcnt(0)\n\ts_barrier" ::: "memory"); }

__device__ __forceinline__ void idx_scores(DL unsigned char* lds, const bf16* Qi, const bf16* Ki, const float* Wi, float* SC, int b, int q0, int tid, int wave, int lane) {
    const int hi = lane >> 5, r32 = lane & 31, t0 = q0 + 2 * wave;
    const size_t rowb = (size_t)b * SEQ;
    bf16x8 af[4]; float wv[16];
    {   const int aq = (r32 >> 2) & 1, ah = (r32 & 3) + 4 * (r32 >> 3);
        const bf16* ap = Qi + (rowb + t0 + aq) * 1024 + ah * 64 + hi * 8;
#pragma unroll
        for (int kk = 0; kk < 4; ++kk) af[kk] = *(const DG bf16x8*)(ap + kk * 16);
        const float* wp = Wi + (rowb + t0 + hi) * 16;
#pragma unroll
        for (int i = 0; i < 4; ++i) { const f32x4 w4 = *(const DG f32x4*)(wp + 4 * i); wv[4 * i] = w4[0]; wv[4 * i + 1] = w4[1]; wv[4 * i + 2] = w4[2]; wv[4 * i + 3] = w4[3]; } }
    const int nch = (q0 + 16 + 255) >> 8;
    u32x4 st[4];
    const int srow = tid >> 3, sc16 = tid & 7;
    const bf16* kg = Ki + (rowb + srow) * 64 + sc16 * 8;
#pragma unroll
    for (int p = 0; p < 4; ++p) st[p] = *(const DG u32x4*)(kg + (size_t)(64 * p) * 64);
#pragma unroll
    for (int p = 0; p < 4; ++p) { const int row = 64 * p + srow; *(DL u32x4*)(lds + L_KBUF + row * 128 + 16 * (sc16 ^ ((row >> 1) & 7))) = st[p]; }
    wg_barrier();
    float* srowp = SC + (rowb + t0 + hi) * (size_t)SEQ + r32;
    DL unsigned* hq = (DL unsigned*)(lds + L_HIST + (2 * wave + hi) * 4096);
    const int tq = t0 + hi;
    for (int c = 0; c < nch; ++c) {
        const bool more = (c + 1 < nch);
        if (more) {
#pragma unroll
            for (int p = 0; p < 4; ++p) st[p] = *(const DG u32x4*)(kg + (size_t)(256 * (c + 1) + 64 * p) * 64); }
        const DL unsigned char* buf = lds + L_KBUF + (c & 1) * 32768;
        const int kbase = 256 * c;
#pragma unroll
        for (int T = 0; T < 8; ++T) {
            const int row = 32 * T + r32; const DL unsigned char* rp = buf + row * 128; const int sw = (row >> 1) & 7;
            f32x16 acc = {0.f, 0.f, 0.f, 0.f, 0.f, 0.f, 0.f, 0.f, 0.f, 0.f, 0.f, 0.f, 0.f, 0.f, 0.f, 0.f};
#pragma unroll
            for (int kk = 0; kk < 4; ++kk) { const bf16x8 bfr = *(const DL bf16x8*)(rp + 16 * ((2 * kk + hi) ^ sw)); acc = __builtin_amdgcn_mfma_f32_32x32x16_bf16(af[kk], bfr, acc, 0, 0, 0); }
            float s0 = 0.f, s1 = 0.f;
#pragma unroll
            for (int r = 0; r < 16; r += 2) { s0 += wv[r] * fmaxf(acc[r], 0.f); s1 += wv[r + 1] * fmaxf(acc[r + 1], 0.f); }
            const float s = s0 + s1;
            *(DG float*)(srowp + kbase + 32 * T) = s;
            { const unsigned bin = ordkey(s) >> 21; const unsigned inc = (kbase + 32 * T + r32 <= tq) ? ((bin & 1u) ? 65536u : 1u) : 0u;
              __hip_atomic_fetch_add(hq + (bin >> 1), inc, __ATOMIC_RELAXED, __HIP_MEMORY_SCOPE_WORKGROUP); }
        }
        if (more) {
#pragma unroll
            for (int p = 0; p < 4; ++p) { const int row = 64 * p + srow; *(DL u32x4*)(lds + L_KBUF + ((c + 1) & 1) * 32768 + row * 128 + 16 * (sc16 ^ ((row >> 1) & 7))) = st[p]; } }
        wg_barrier();
    }
}

__device__ __forceinline__ void hist_scan(const DL unsigned* hist, unsigned need, int lane, int& tb, unsigned& above) {
    u32x4 w[4];
#pragma unroll
    for (int i = 0; i < 4; ++i) w[i] = *(const DL u32x4*)(hist + 16 * lane + 4 * i);
    unsigned tot = 0u;
#pragma unroll
    for (int i = 0; i < 4; ++i)
#pragma unroll
        for (int e = 0; e < 4; ++e) tot += (w[i][e] & 0xffffu) + (w[i][e] >> 16);
    unsigned incl = tot;
#pragma unroll
    for (int o = 1; o < 64; o <<= 1) { const unsigned tv = __shfl_down(incl, o); if (lane + o < 64) incl += tv; }
    const unsigned excl = incl - tot;
    const unsigned long long hm = __ballot((excl < need) && (need <= incl));
    const int Ls = hm ? (int)__builtin_ctzll(hm) : 0;
    const unsigned exL = (unsigned)__shfl((int)excl, Ls);
    const unsigned cj = lane < 32 ? (unsigned)((const DL unsigned short*)hist)[32 * Ls + lane] : 0u;
    unsigned sfx = cj;
#pragma unroll
    for (int o = 1; o < 64; o <<= 1) { const unsigned tv = __shfl_down(sfx, o); if (lane + o < 64) sfx += tv; }
    const unsigned long long cm = __ballot(lane < 32 && exL + sfx >= need);
    const int tbl = cm ? 63 - (int)__builtin_clzll(cm) : 0;
    tb = 32 * Ls + tbl; above = exL + (unsigned)__shfl((int)(sfx - cj), tbl);
}
__device__ __forceinline__ void hist_zero(DL unsigned* hist, int lane) {
#pragma unroll
    for (int i = 0; i < 4; ++i) *(DL u32x4*)(hist + 4 * lane + 256 * i) = (u32x4){0u, 0u, 0u, 0u};
    asm volatile("s_waitcnt lgkmcnt(0)" ::: "memory");
}
__device__ __forceinline__ void select_stream(const float* srow, int n, DL unsigned* hist, DL unsigned* sel, int lane, unsigned prefix, int need) {
    const int nq = (n + 255) >> 8;
#pragma unroll
    for (int pass = 1; pass < 3; ++pass) {
        const int sh = pass == 1 ? 10 : 0; const unsigned bmask = pass == 2 ? 1023u : 2047u;
        hist_zero(hist, lane);
        for (int i = 0; i < nq; ++i) {
            const int j = 256 * i + 4 * lane;
            const f32x4 x = *(const DG f32x4*)(srow + j);
#pragma unroll
            for (int e = 0; e < 4; ++e) {
                const unsigned key = ordkey(x[e]);
                const bool ok = (j + e < n) && (pass == 1 ? ((key >> 21) == (prefix >> 21)) : ((key >> 10) == (prefix >> 10)));
                const unsigned bin = (key >> sh) & bmask;
                __hip_atomic_fetch_add(hist + (bin >> 1), ok ? ((bin & 1u) ? 65536u : 1u) : 0u, __ATOMIC_RELAXED, __HIP_MEMORY_SCOPE_WORKGROUP);
            }
        }
        asm volatile("s_waitcnt lgkmcnt(0)" ::: "memory");
        int tb; unsigned above; hist_scan(hist, (unsigned)need, lane, tb, above);
        prefix |= ((unsigned)tb << sh); need -= (int)above;
    }
    const unsigned T = prefix; const int need3 = need, above_total = 256 - need3;
    int base_gt = 0, base_eq = 0;
    const int ni = (n + 63) >> 6;
    for (int i = 0; i < ni; ++i) {
        const int j = 64 * i + lane; const bool valid = j < n;
        const float x = valid ? *(const DG float*)(srow + j) : 0.f; const unsigned key = ordkey(x);
        const bool gt = valid && key > T, eq = valid && key == T;
        const unsigned long long bg = __ballot(gt), be = __ballot(eq);
        const int pg = (int)mbcnt64(bg), pe = (int)mbcnt64(be);
        if (gt) sel[base_gt + pg] = (unsigned)j;
        if (eq && base_eq + pe < need3) sel[above_total + base_eq + pe] = (unsigned)j;
        base_gt += __builtin_popcountll(bg); base_eq += __builtin_popcountll(be);
    }
    asm volatile("s_waitcnt lgkmcnt(0)" ::: "memory");
}
__device__ __forceinline__ void topk256(const float* srow, int n, DL unsigned* hist, DL unsigned* sel, DL unsigned* cand  , int lane) {
    int tb; unsigned above; hist_scan(hist, 256u, lane, tb, above);
    int need = 256 - (int)above;
    const int nq = (n + 255) >> 8;
    int base_gt = 0, base_c = 0;
    f32x4 xn = *(const DG f32x4*)(srow + 4 * lane);
    for (int i = 0; i < nq; ++i) {
        const f32x4 x = xn; const int j = 256 * i + 4 * lane;
        if (i + 1 < nq) xn = *(const DG f32x4*)(srow + j + 256);
#pragma unroll
        for (int e = 0; e < 4; ++e) {
            const unsigned key = ordkey(x[e]); const int bin = (int)(key >> 21); const bool valid = (j + e < n);
            const bool gt = valid && bin > tb, eq = valid && bin == tb;
            const unsigned long long bg = __ballot(gt), be = __ballot(eq);
            const int pg = base_gt + (int)mbcnt64(bg), pc = base_c + (int)mbcnt64(be);
            if (gt) sel[pg] = (unsigned)(j + e);
            if (eq && pc < CAND_CAP) { cand[pc] = key; cand[CAND_CAP + pc] = (unsigned)(j + e); }
            base_gt += __builtin_popcountll(bg); base_c += __builtin_popcountll(be);
        }
    }
    asm volatile("s_waitcnt lgkmcnt(0)" ::: "memory");
    if (base_c > CAND_CAP) { select_stream(srow, n, hist, sel, lane, (unsigned)tb << 21, need); return; }
    const int C = base_c, nk = (C + 63) >> 6;
    unsigned prefix = (unsigned)tb << 21;
#pragma unroll
    for (int pass = 1; pass < 3; ++pass) {
        const int sh = pass == 1 ? 10 : 0; const unsigned bmask = pass == 2 ? 1023u : 2047u;
        hist_zero(hist, lane);
        for (int k = 0; k < nk; ++k) { const int c = 64 * k + lane;
            if (c < C) { const unsigned key = cand[c]; const bool ok = pass == 1 ? true : ((key >> 10) == (prefix >> 10)); const unsigned bin = (key >> sh) & bmask;
                __hip_atomic_fetch_add(hist + (bin >> 1), ok ? ((bin & 1u) ? 65536u : 1u) : 0u, __ATOMIC_RELAXED, __HIP_MEMORY_SCOPE_WORKGROUP); } }
        asm volatile("s_waitcnt lgkmcnt(0)" ::: "memory");
        int tb2; unsigned ab2; hist_scan(hist, (unsigned)need, lane, tb2, ab2);
        prefix |= ((unsigned)tb2 << sh); need -= (int)ab2;
    }
    const unsigned T = prefix; const int need3 = need;
    for (int k = 0; k < nk; ++k) { const int c = 64 * k + lane; const bool gt = (c < C) && cand[c] > T;
        const unsigned long long bg = __ballot(gt);
        if (gt) sel[base_gt + (int)mbcnt64(bg)] = cand[CAND_CAP + c];
        base_gt += __builtin_popcountll(bg); }
    int last = -1;
    for (int r = 0; r < need3; ++r) {
        int best = 0x7fffffff;
        for (int k = 0; k < nk; ++k) { const int c = 64 * k + lane; if (c < C && cand[c] == T) { const int idx = (int)cand[CAND_CAP + c]; if (idx > last && idx < best) best = idx; } }
#pragma unroll
        for (int o = 1; o < 64; o <<= 1) { const int ov = __shfl_xor(best, o); best = ov < best ? ov : best; }
        if (lane == 0) sel[base_gt + r] = (unsigned)best;
        last = best;
    }
    asm volatile("s_waitcnt lgkmcnt(0)" ::: "memory");
}

__device__ __forceinline__ s16x4 vtr(DL const unsigned char* p) { typedef short v4i16_t __attribute__((ext_vector_type(4))); return __builtin_bit_cast(s16x4, __builtin_amdgcn_ds_read_tr16_b64_v4i16((DL v4i16_t*)p)); }
__device__ __forceinline__ unsigned cvtpk(float lo, float hi) { typedef float f2 __attribute__((ext_vector_type(2))); typedef __bf16 b2 __attribute__((ext_vector_type(2))); f2 v = {lo, hi}; b2 r = __builtin_convertvector(v, b2); return __builtin_bit_cast(unsigned, r); }
__device__ __forceinline__ unsigned offb(unsigned row, unsigned ch) { return 256u * row + 16u * (ch ^ (((row & 3u) << 2) | ((row >> 2) & 3u))); }
__device__ __forceinline__ void sparse_attn(DL unsigned char* vst, const DL unsigned* sel, int nsel, const bf16* Qs, const unsigned char* Ks8, const unsigned char* Vs8, bf16* MIX, int b, int t, int lane) {
    typedef float f2 __attribute__((ext_vector_type(2)));
    const int c16 = lane & 15, g = lane >> 4; const size_t rowb = (size_t)b * SEQ;
    long qf[4];
    {   const bf16* qp = Qs + (rowb + t) * 1024 + (c16 & 7) * 128 + g * 32;
#pragma unroll
        for (int kk = 0; kk < 4; ++kk) { const u32x4 w = *(const DG u32x4*)(qp + kk * 8);
            float f[8];
#pragma unroll
            for (int i = 0; i < 4; ++i) { f[2 * i] = __uint_as_float(w[i] << 16) * 8.0f; f[2 * i + 1] = __uint_as_float(w[i] & 0xffff0000u) * 8.0f; }
            int lo = __builtin_amdgcn_cvt_pk_fp8_f32(f[0], f[1], 0, false); lo = __builtin_amdgcn_cvt_pk_fp8_f32(f[2], f[3], lo, true);
            int hi = __builtin_amdgcn_cvt_pk_fp8_f32(f[4], f[5], 0, false); hi = __builtin_amdgcn_cvt_pk_fp8_f32(f[6], f[7], hi, true);
            qf[kk] = (long)(((unsigned long long)(unsigned)hi << 32) | (unsigned long long)(unsigned)lo); } }
    const int nblk = (nsel + 31) >> 5;
    f32x4 o[8];
#pragma unroll
    for (int c = 0; c < 8; ++c) o[c] = (f32x4){0.f, 0.f, 0.f, 0.f};
    float mrun = -INFINITY, l = 0.f;
    const unsigned q4 = (unsigned)(c16 >> 2), p4 = (unsigned)(lane & 3);
    const DG unsigned char* Kb = (const DG unsigned char*)(Ks8 + rowb * 128); const DG unsigned char* Vb = (const DG unsigned char*)(Vs8 + rowb * 128);
    const unsigned koff = (unsigned)g * 32u, voff = (unsigned)(lane & 7) * 16u;
    u32x4 kw[2][2], vv[4];
#define DSA_LOADK(TB) do { _Pragma("unroll") for (int tt = 0; tt < 2; ++tt) { const int jj = 32 * (TB) + 16 * tt + c16; const unsigned idx = jj < nsel ? sel[jj] : 0u; \
        kw[tt][0] = *(const DG u32x4*)(Kb + (idx * 128u + koff)); kw[tt][1] = *(const DG u32x4*)(Kb + (idx * 128u + koff + 16u)); } } while (0)
#define DSA_LOADV(TB) do { _Pragma("unroll") for (int pp = 0; pp < 4; ++pp) { const int j = 32 * (TB) + 8 * pp + (lane >> 3); const unsigned idx = j < nsel ? sel[j] : 0u; \
        vv[pp] = *(const DG u32x4*)(Vb + (idx * 128u + voff)); } } while (0)
    DSA_LOADK(0); DSA_LOADV(0);
    for (int Tb = 0; Tb < nblk; ++Tb) {
        f32x4 sv[2];
#pragma unroll
        for (int tt = 0; tt < 2; ++tt) {
            f32x4 acc = {0.f, 0.f, 0.f, 0.f};
#pragma unroll
            for (int kk = 0; kk < 4; ++kk) { const u32x4 w = kw[tt][kk >> 1]; const unsigned lo = (kk & 1) ? w.z : w.x, hi = (kk & 1) ? w.w : w.y;
                acc = __builtin_amdgcn_mfma_f32_16x16x32_fp8_fp8((long)(((unsigned long long)hi << 32) | (unsigned long long)lo), qf[kk], acc, 0, 0, 0); }
#pragma unroll
            for (int r = 0; r < 4; ++r) acc[r] = (32 * Tb + 16 * tt + 4 * g + r >= nsel) ? -INFINITY : acc[r] * 0.125f;
            sv[tt] = acc;
        }
        if (Tb + 1 < nblk) DSA_LOADK(Tb + 1);
        float bm = fmaxf(fmaxf(fmaxf(sv[0][0], sv[0][1]), fmaxf(sv[0][2], sv[0][3])), fmaxf(fmaxf(sv[1][0], sv[1][1]), fmaxf(sv[1][2], sv[1][3])));
        bm = fmaxf(bm, __shfl_xor(bm, 16)); bm = fmaxf(bm, __shfl_xor(bm, 32));
        const float mnew = fmaxf(mrun, bm), alpha = __builtin_amdgcn_exp2f(mrun - mnew); mrun = mnew;
        float ps = 0.f;
#pragma unroll
        for (int tt = 0; tt < 2; ++tt)
#pragma unroll
            for (int r = 0; r < 4; ++r) { const float p = __builtin_amdgcn_exp2f(sv[tt][r] - mnew); sv[tt][r] = p; ps += p; }
        l = l * alpha + ps;
#pragma unroll
        for (int c = 0; c < 8; ++c) o[c] = o[c] * alpha;
        asm volatile("s_waitcnt lgkmcnt(0)" ::: "memory");
#pragma unroll
        for (int pp = 0; pp < 4; ++pp) {
            const int jj = 8 * pp + (lane >> 3); const unsigned rho = 8u * ((jj & 15) >> 2) + 4u * (jj >> 4) + (jj & 3), ch0 = 2u * (lane & 7);
            u32x4 wlo, whi;
#pragma unroll
            for (int d = 0; d < 4; ++d) { const f2 a = __builtin_amdgcn_cvt_pk_f32_fp8((int)vv[pp][d], false), c2 = __builtin_amdgcn_cvt_pk_f32_fp8((int)vv[pp][d], true);
                const unsigned w0 = cvtpk(a[0], a[1]), w1 = cvtpk(c2[0], c2[1]);
                if (d < 2) { wlo[2 * d] = w0; wlo[2 * d + 1] = w1; } else { whi[2 * (d - 2)] = w0; whi[2 * (d - 2) + 1] = w1; } }
            *(DL u32x4*)(vst + offb(rho, ch0)) = wlo; *(DL u32x4*)(vst + offb(rho, ch0 + 1u)) = whi; }
        if (Tb + 1 < nblk) DSA_LOADV(Tb + 1);
        asm volatile("s_waitcnt lgkmcnt(0)" ::: "memory");
        u32x4 pw; pw.x = cvtpk(sv[0][0], sv[0][1]); pw.y = cvtpk(sv[0][2], sv[0][3]); pw.z = cvtpk(sv[1][0], sv[1][1]); pw.w = cvtpk(sv[1][2], sv[1][3]);
        const bf16x8 pa = __builtin_bit_cast(bf16x8, pw);
#pragma unroll
        for (int c = 0; c < 8; ++c) {
            const unsigned ch = 2u * c + (p4 >> 1);
            const s16x4 lo = vtr(vst + offb(8u * g + q4, ch) + 8u * (p4 & 1)), hi4 = vtr(vst + offb(8u * g + 4u + q4, ch) + 8u * (p4 & 1));
            const bf16x8 vfr = (bf16x8){lo[0], lo[1], lo[2], lo[3], hi4[0], hi4[1], hi4[2], hi4[3]};
            o[c] = __builtin_amdgcn_mfma_f32_16x16x32_bf16(vfr, pa, o[c], 0, 0, 0);
        }
    }
#undef DSA_LOADK
#undef DSA_LOADV
    l += __shfl_xor(l, 16); l += __shfl_xor(l, 32);
    const float linv = 1.0f / l;
    if (c16 < 8) {
        bf16* op = MIX + (rowb + t) * 2048 + 1024 + c16 * 128 + 4 * g;
#pragma unroll
        for (int c = 0; c < 8; ++c) { typedef unsigned u32x2 __attribute__((ext_vector_type(2))); u32x2 w2; w2.x = cvtpk(o[c][0] * linv, o[c][1] * linv); w2.y = cvtpk(o[c][2] * linv, o[c][3] * linv); *(DG u32x2*)(op + 16 * c) = w2; }
    }
}

struct DsaTensors { const bf16* Qi; const bf16* Ki; const float* Wi; const bf16* Qs; const bf16* Ks; const bf16* Vs; bf16* MIX; float* SC; const unsigned char* Ks8; const unsigned char* Vs8; };
template <class Hook>
__device__ __forceinline__ void dsa_unit(DL unsigned char* lds, const DsaTensors& T, int b, int q0, int tid, int wave, int lane, const Hook& hook, int slot0) {
    wg_barrier();
#pragma unroll
    for (int i = 0; i < 8; ++i) *(DL u32x4*)(lds + L_HIST + (i * 512 + tid) * 16) = (u32x4){0u, 0u, 0u, 0u};
#ifndef NO_IDX
    idx_scores(lds, T.Qi, T.Ki, T.Wi, T.SC, b, q0, tid, wave, lane);
#endif
    asm volatile("s_waitcnt vmcnt(0)" ::: "memory");
    DL unsigned* sel = (DL unsigned*)(lds + L_SEL + wave * 1280); DL unsigned char* vst = lds + L_KBUF + wave * 8192;
#pragma unroll 1
    for (int qi = 0; qi < 2; ++qi) {
        const int t = q0 + 2 * wave + qi, n = t + 1;
        int nsel;
        if (n <= 256) { for (int j = lane; j < 256; j += 64) sel[j] = j < n ? (unsigned)j : 0u; asm volatile("s_waitcnt lgkmcnt(0)" ::: "memory"); nsel = n; }
        else {
#ifndef NO_TOPK
            topk256(T.SC + ((size_t)b * SEQ + t) * SEQ, n, (DL unsigned*)(lds + L_HIST + (2 * wave + qi) * 4096), sel, (DL unsigned*)vst, lane);
#endif
            nsel = 256; }
#ifndef NO_SPARSE
        { int l2 = lane; asm volatile("" : "+v"(l2) :: "memory"); __builtin_amdgcn_sched_barrier(0);
          sparse_attn(vst, sel, nsel, T.Qs, T.Ks8, T.Vs8, T.MIX, b, t, l2);
          asm volatile("s_waitcnt lgkmcnt(0)" ::: "memory"); hook(slot0 + qi, vst, l2); }
#endif
    }
}
template <class Hook>
__device__ __forceinline__ void dsa_phase(DL unsigned char* lds, const DsaTensors& T, int vcu, int G, int tid, int wave, int lane, const Hook& hook) {
    if (G == 256) {
#pragma unroll 1
        for (int it = 0; it < 2; ++it) { const int L = it ? 511 - vcu : vcu; dsa_unit(lds, T, L >> 8, 16 * (L & 255), tid, wave, lane, hook, 2 * it); }
    } else {
#pragma unroll 1
        for (int L = vcu; L < 512; L += G) dsa_unit(lds, T, L >> 8, 16 * (L & 255), tid, wave, lane, hook, 4);
    }
}
#undef DL
#undef DG
}
constexpr int NWAVES = 8;
constexpr int RING_OFF = 0, RING_BYTES = 143360;
constexpr int LDSCTL_OFF = RING_BYTES, MISC_OFF = LDSCTL_OFF + 320;
constexpr int LDS_BYTES = 147456;
static_assert(MISC_OFF + 128 <= LDS_BYTES, "LDS map");

struct Args { const void* in[19]; float* out; unsigned char* ws; int ph_lo, ph_hi; };
static_assert(sizeof(Args) == 19 * 8 + 8 + 8 + 8, "Args has no padding");

struct Frame {
    LAS unsigned char* lds;
    volatile LAS unsigned* MISC;
    gu32* ctl;
    int tid, lane, wave;
    int vcu, G;
};

__device__ __forceinline__ float wave_sum(float v) {
#pragma unroll
    for (int o = 1; o < 64; o <<= 1) v += __shfl_xor(v, o);
    return v;
}
template <class RowMap>
__device__ __forceinline__ void p0_transpose_item(const float* W, int K, int ldw, int nvalid, bf16* WT, LAS float* scr, int kb, int nb, int lane, RowMap rm) {
    const int k0 = 64 * kb, n0 = 32 * nb;
    const int n4 = 4 * (lane & 7), kr = lane >> 3;
    f32x4 v[8];
    if (n0 + 32 <= nvalid && (ldw & 3) == 0) {
#pragma unroll
        for (int i = 0; i < 8; ++i) v[i] = *(const GAS f32x4*)(W + (size_t)(k0 + kr + 8 * i) * ldw + n0 + n4);
    } else {
#pragma unroll
        for (int i = 0; i < 8; ++i) { const float* p = W + (size_t)(k0 + kr + 8 * i) * ldw + n0 + n4;
            v[i].x = (n0 + n4 + 0 < nvalid) ? p[0] : 0.f; v[i].y = (n0 + n4 + 1 < nvalid) ? p[1] : 0.f; v[i].z = (n0 + n4 + 2 < nvalid) ? p[2] : 0.f; v[i].w = (n0 + n4 + 3 < nvalid) ? p[3] : 0.f; }
    }
#pragma unroll
    for (int i = 0; i < 8; ++i) *(LAS f32x4*)(scr + (kr + 8 * i) * 32 + (n4 ^ (4 * i))) = v[i];
    LDS_WAIT(); asm volatile("" ::: "memory");
    const int c = lane & 7;
#pragma unroll
    for (int j = 0; j < 4; ++j) { const int n = (lane >> 3) + 8 * j; const LAS float* s = scr + (8 * c) * 32 + (n ^ (4 * c));
        v4u o; o.x = pk2(s[0 * 32], s[1 * 32]); o.y = pk2(s[2 * 32], s[3 * 32]); o.z = pk2(s[4 * 32], s[5 * 32]); o.w = pk2(s[6 * 32], s[7 * 32]);
        *(GAS v4u*)(WT + (size_t)rm(n0 + n) * K + k0 + 8 * c) = o; }
    LDS_WAIT(); asm volatile("" ::: "memory");
}
struct RmId { __device__ __forceinline__ int operator()(int n) const { return n; } };
struct RmGate { int add; __device__ __forceinline__ int operator()(int n) const { return 256 * (n >> 7) + (n & 127) + add; } };

constexpr int I_FG = 32 * (FF / 32), I_FD = (FF / 64) * (DM / 32), N_FFN_ITEMS = 2 * I_FG + I_FD;
constexpr int P2_IDLE_FIRST = 192, P2_IDLE_PER_WAVE = 13, N_FFN_P2 = (256 - P2_IDLE_FIRST) * 8 * P2_IDLE_PER_WAVE;
__device__ __forceinline__ void ffn_transpose_item(const float* w_gate, const float* w_up, const float* w_down, bf16* Wgu_t, bf16* Wd_t, LAS float* scr, int r, int lane) {
    if (r < I_FG) { p0_transpose_item(w_gate, DM, FF, FF, Wgu_t, scr, r / (FF / 32), r % (FF / 32), lane, RmGate{0}); return; } r -= I_FG;
    if (r < I_FG) { p0_transpose_item(w_up, DM, FF, FF, Wgu_t, scr, r / (FF / 32), r % (FF / 32), lane, RmGate{128}); return; } r -= I_FG;
    p0_transpose_item(w_down, FF, DM, DM, Wd_t, scr, r / (DM / 32), r % (DM / 32), lane, RmId{});
}
struct FfnHook {
    const float *w_gate, *w_up, *w_down; bf16 *Wgu_t, *Wd_t; int gw, NGW;
    __device__ __forceinline__ void operator()(int slot, LAS unsigned char* scr, int lane) const {
        if (slot > 3) return;
        if (slot > 2) return;
        const int it = N_FFN_P2 + gw + NGW * slot; if (it < 2 * I_FG) ffn_transpose_item(w_gate, w_up, w_down, Wgu_t, Wd_t, (LAS float*)scr, it, lane);
    }
};
__device__ __forceinline__ void p0_prologue(Frame& F, const Args& A) {
    const float* c = (const float*)A.in[1]; const int* pos = (const int*)A.in[2]; const float* w_ada = (const float*)A.in[3];
    const float* w_in = (const float*)A.in[9]; const float* w_o = (const float*)A.in[15]; const float* w_gate = (const float*)A.in[16]; const float* w_up = (const float*)A.in[17]; const float* w_down = (const float*)A.in[18];
    unsigned char* ws = A.ws;
    bf16* Win_t = (bf16*)(ws + WS_WIN); bf16* Wo_t = (bf16*)(ws + WS_WO); bf16* Wgu_t = (bf16*)(ws + WS_WGU); bf16* Wd_t = (bf16*)(ws + WS_WD);
    float* MODP = (float*)(ws + WS_MODP); float* ROPE = (float*)(ws + WS_ROPE);
    const int gw = F.vcu * NWAVES + F.wave, NGW = F.G * NWAVES;
    for (int g = F.vcu * 512 + F.tid; g < M * 24; g += F.G * 512) {
        const int m = g / 24, i = g % 24; const float p = (float)pos[m];
        if (i < 8) { const float inv = powf(500000.f, -((float)(2 * i) / 16.f)); const float a = p * inv; ROPE[m * 48 + i] = cosf(a); ROPE[m * 48 + 8 + i] = sinf(a); }
        else { const int k = i - 8; const float inv = powf(500000.f, -((float)(2 * k) / 32.f)); const float a = p * inv; ROPE[m * 48 + 16 + k] = cosf(a); ROPE[m * 48 + 32 + k] = sinf(a); }
    }
    constexpr int KR = DM / ADA_KC;
    constexpr int N_ADA = ADA_KC * (NADA / 256);
    LAS float* scr = (LAS float*)(F.lds + RING_OFF + F.wave * 16384);
#ifdef PROBE_ADA2
    for (int rep = 0; rep < 2; ++rep)
#endif
    for (int it = gw; it < N_ADA; it += NGW) {
        const int kc = it / (NADA / 256), cc = it % (NADA / 256);
#pragma unroll
        for (int j = 0; j < 4; ++j) { const int idx = F.lane + 64 * j; const int b = idx >> 7, k = idx & 127; const float v = c[b * DM + kc * KR + k]; scr[idx] = v / (1.f + expf(-v)); }
        LDS_WAIT(); asm volatile("" ::: "memory");
        const float* wp = w_ada + (size_t)(kc * KR) * NADA + cc * 256 + 4 * F.lane;
        f32x4 a0 = {0.f, 0.f, 0.f, 0.f}, a1 = {0.f, 0.f, 0.f, 0.f};
#pragma unroll 8
        for (int k = 0; k < KR; ++k) { const f32x4 w = *(const GAS f32x4*)(wp + (size_t)k * NADA); const float s0 = scr[k], s1 = scr[128 + k]; a0 += w * s0; a1 += w * s1; }
        *(GAS f32x4*)(MODP + (size_t)(kc * 2 + 0) * NADA + cc * 256 + 4 * F.lane) = a0;
        *(GAS f32x4*)(MODP + (size_t)(kc * 2 + 1) * NADA + cc * 256 + 4 * F.lane) = a1;
        LDS_WAIT(); asm volatile("" ::: "memory");
    }
    constexpr int I_IN = 32 * (NPROJ_PAD / 32), I_O = 32 * (DM / 32), I_G = 32 * (FF / 32), I_D = (FF / 64) * (DM / 32);
    const bool ffn_later = (F.G == 256);
    const int NT_ITEMS = ffn_later ? I_IN + I_O : I_IN + I_O + 2 * I_G + I_D;
    const int ADA_SHARE = ffn_later ? 0 : 8;
    int it, step, end;
    if (NGW > N_ADA) { if (gw < N_ADA) { it = gw; step = N_ADA; end = N_ADA * ADA_SHARE; } else { it = N_ADA * ADA_SHARE + (gw - N_ADA); step = NGW - N_ADA; end = NT_ITEMS; } }
    else { it = gw; step = NGW; end = NT_ITEMS; }
#ifdef PROBE_TR2
    const int it0 = it;
    for (int rep = 0; rep < 2; ++rep)
    for (it = it0; it < end; it += step) {
#else
    for (; it < end; it += step) {
#endif
        int r = it;
        if (r < I_IN) { p0_transpose_item(w_in, DM, NPROJ, NPROJ, Win_t, scr, r / (NPROJ_PAD / 32), r % (NPROJ_PAD / 32), F.lane, RmId{}); continue; } r -= I_IN;
        if (r < I_O)  { p0_transpose_item(w_o, DM, DM, DM, Wo_t, scr, r / (DM / 32), r % (DM / 32), F.lane, RmId{}); continue; } r -= I_O;
        if (r < I_G)  { p0_transpose_item(w_gate, DM, FF, FF, Wgu_t, scr, r / (FF / 32), r % (FF / 32), F.lane, RmGate{0}); continue; } r -= I_G;
        if (r < I_G)  { p0_transpose_item(w_up, DM, FF, FF, Wgu_t, scr, r / (FF / 32), r % (FF / 32), F.lane, RmGate{128}); continue; } r -= I_G;
        p0_transpose_item(w_down, FF, DM, DM, Wd_t, scr, r / (DM / 32), r % (DM / 32), F.lane, RmId{});
    }
}
__device__ __forceinline__ void p1_norm(Frame& F, const Args& A) {
    const float* x = (const float*)A.in[0]; const float* b_ada = (const float*)A.in[4]; const float* g_pre = (const float*)A.in[5];
    unsigned char* ws = A.ws; const float* MODP = (const float*)(ws + WS_MODP); float* MOD = (float*)(ws + WS_MOD); bf16* XN = (bf16*)(ws + WS_XN);
    LAS float* sv = (LAS float*)(F.lds + RING_OFF);
    const int rows_per_wg = M / F.G;
    const int m0 = F.vcu * rows_per_wg, b = m0 / SEQ;
    for (int i = F.tid; i < 2 * DM; i += 512) { float s = b_ada[i];
#pragma unroll 4
        for (int kc = 0; kc < ADA_KC; ++kc) s += MODP[(size_t)(kc * 2 + b) * NADA + i];
        sv[i] = s; }
    { const int per = (BATCH * NADA + F.G - 1) / F.G;
      for (int i = F.tid; i < per; i += 512) { const int idx = F.vcu * per + i; if (idx < BATCH * NADA) { const int bb = idx / NADA, j = idx % NADA; float s = b_ada[j];
#pragma unroll 4
            for (int kc = 0; kc < ADA_KC; ++kc) s += MODP[(size_t)(kc * 2 + bb) * NADA + j];
            MOD[idx] = s; } } }
    LDS_WAIT(); __syncthreads();
    for (int r = F.wave; r < rows_per_wg; r += NWAVES) {
        const int m = m0 + r;
        const GAS f32x4* xr = (const GAS f32x4*)(x + (size_t)m * DM) + F.lane;
        f32x4 v[8]; float s = 0.f;
#pragma unroll
        for (int j = 0; j < 8; ++j) { v[j] = xr[64 * j]; s += (v[j].x * v[j].x + v[j].y * v[j].y) + (v[j].z * v[j].z + v[j].w * v[j].w); }
        const float rstd = 1.0f / sqrtf(wave_sum(s) * (1.f / DM) + RMS_EPS);
        GAS unsigned long long* o8 = (GAS unsigned long long*)(XN + (size_t)m * DM) + F.lane;
#pragma unroll
        for (int j = 0; j < 8; ++j) { const int col = 4 * F.lane + 256 * j; const f32x4 g = *(const GAS f32x4*)(g_pre + col);
            const f32x4 sh = *(const LAS f32x4*)(sv + col), sc = *(const LAS f32x4*)(sv + DM + col);
            const f32x4 o = v[j] * rstd * g * (sc + 1.0f) + sh;
            o8[64 * j] = (unsigned long long)pk2(o.x, o.y) | ((unsigned long long)pk2(o.z, o.w) << 32); }
    }
}


__device__ __forceinline__ void p6_post1(Frame& F, const Args& A) {
    const float* x = (const float*)A.in[0]; const float* g_post = (const float*)A.in[6]; const float* g_pre2 = (const float*)A.in[7];
    unsigned char* ws = A.ws; const float* MOD = (const float*)(ws + WS_MOD); const bf16* MIXOUT = (const bf16*)(ws + WS_MIXOUT); bf16* XN = (bf16*)(ws + WS_XN); float* X1 = A.out;
    LAS float* A1 = (LAS float*)(F.lds + RING_OFF); LAS float* A2 = A1 + DM; LAS float* A3 = A2 + DM;
    const int rows_per_wg = M / F.G; const int m0 = F.vcu * rows_per_wg, b = m0 / SEQ; const float* md = MOD + (size_t)b * NADA;
    for (int j = F.tid; j < DM; j += 512) { A1[j] = md[2 * DM + j] * g_post[j]; A2[j] = g_pre2[j] * (1.0f + md[4 * DM + j]); A3[j] = md[3 * DM + j]; }
    LDS_WAIT(); __syncthreads();
    for (int r = F.wave; r < rows_per_wg; r += NWAVES) {
        const int m = m0 + r;
        const GAS unsigned long long* mr = (const GAS unsigned long long*)(MIXOUT + (size_t)m * DM) + F.lane; const GAS f32x4* xr = (const GAS f32x4*)(x + (size_t)m * DM) + F.lane;
        GAS f32x4* o1 = (GAS f32x4*)(X1 + (size_t)m * DM) + F.lane;
        f32x4 v[8]; float s = 0.f;
#pragma unroll
        for (int j = 0; j < 8; ++j) { const unsigned long long w = mr[64 * j]; const unsigned lo = (unsigned)w, hi = (unsigned)(w >> 32);
            v[j] = (f32x4){__uint_as_float(lo << 16), __uint_as_float(lo & 0xffff0000u), __uint_as_float(hi << 16), __uint_as_float(hi & 0xffff0000u)};
            s += (v[j].x * v[j].x + v[j].y * v[j].y) + (v[j].z * v[j].z + v[j].w * v[j].w); }
        const float rstd = 1.0f / sqrtf(wave_sum(s) * (1.f / DM) + RMS_EPS);
        float s2 = 0.f;
#pragma unroll
        for (int j = 0; j < 8; ++j) { const int col = 4 * F.lane + 256 * j; const f32x4 a1 = *(const LAS f32x4*)(A1 + col);
            v[j] = xr[64 * j] + (v[j] * rstd) * a1; o1[64 * j] = v[j]; s2 += (v[j].x * v[j].x + v[j].y * v[j].y) + (v[j].z * v[j].z + v[j].w * v[j].w); }
        const float rstd2 = 1.0f / sqrtf(wave_sum(s2) * (1.f / DM) + RMS_EPS);
        GAS unsigned long long* o8 = (GAS unsigned long long*)(XN + (size_t)m * DM) + F.lane;
#pragma unroll
        for (int j = 0; j < 8; ++j) { const int col = 4 * F.lane + 256 * j; const f32x4 a2 = *(const LAS f32x4*)(A2 + col), a3 = *(const LAS f32x4*)(A3 + col);
            const f32x4 o = (v[j] * rstd2) * a2 + a3;
            o8[64 * j] = (unsigned long long)pk2(o.x, o.y) | ((unsigned long long)pk2(o.z, o.w) << 32); }
    }
}
__device__ __forceinline__ void p9_post2(Frame& F, const Args& A) {
    const float* g_post = (const float*)A.in[8];
    unsigned char* ws = A.ws; const float* MOD = (const float*)(ws + WS_MOD); const bf16* FFO = (const bf16*)(ws + WS_FFO); float* X1 = A.out;
    LAS float* A1 = (LAS float*)(F.lds + RING_OFF);
    const int rows_per_wg = M / F.G; const int m0 = F.vcu * rows_per_wg, b = m0 / SEQ; const float* md = MOD + (size_t)b * NADA;
    for (int j = F.tid; j < DM; j += 512) A1[j] = md[5 * DM + j] * g_post[j];
    LDS_WAIT(); __syncthreads();
    for (int r = F.wave; r < rows_per_wg; r += NWAVES) {
        const int m = m0 + r;
        const GAS unsigned long long* fr = (const GAS unsigned long long*)(FFO + (size_t)m * DM) + F.lane; GAS f32x4* o1 = (GAS f32x4*)(X1 + (size_t)m * DM) + F.lane;
        f32x4 v[8]; float s = 0.f;
#pragma unroll
        for (int j = 0; j < 8; ++j) { const unsigned long long w = fr[64 * j]; const unsigned lo = (unsigned)w, hi = (unsigned)(w >> 32);
            v[j] = (f32x4){__uint_as_float(lo << 16), __uint_as_float(lo & 0xffff0000u), __uint_as_float(hi << 16), __uint_as_float(hi & 0xffff0000u)};
            s += (v[j].x * v[j].x + v[j].y * v[j].y) + (v[j].z * v[j].z + v[j].w * v[j].w); }
        const float rstd = 1.0f / sqrtf(wave_sum(s) * (1.f / DM) + RMS_EPS);
#pragma unroll
        for (int j = 0; j < 8; ++j) { const int col = 4 * F.lane + 256 * j; const f32x4 a1 = *(const LAS f32x4*)(A1 + col); o1[64 * j] = o1[64 * j] + (v[j] * rstd) * a1; }
    }
}


__device__ __forceinline__ void p4_combine(Frame& F, const Args& A) {
    const float* lq1 = (const float*)A.in[10]; const float* lk1 = (const float*)A.in[11]; const float* lq2 = (const float*)A.in[12]; const float* lk2 = (const float*)A.in[13]; const float* g_diff = (const float*)A.in[14];
    unsigned char* ws = A.ws; const bf16* O1 = (const bf16*)(ws + WS_O1); const bf16* O2 = (const bf16*)(ws + WS_O2); bf16* MIX = (bf16*)(ws + WS_MIX);
    const float lam = expf(wave_sum(lq1[F.lane] * lk1[F.lane])) - expf(wave_sum(lq2[F.lane] * lk2[F.lane])) + 0.2f;
    float gd[16];
#pragma unroll
    for (int i = 0; i < 4; ++i) { const f32x4 g4 = *(const GAS f32x4*)(g_diff + 16 * (F.lane & 7) + 4 * i); gd[4 * i] = g4.x * 0.8f; gd[4 * i + 1] = g4.y * 0.8f; gd[4 * i + 2] = g4.z * 0.8f; gd[4 * i + 3] = g4.w * 0.8f; }
    const int gw = F.vcu * NWAVES + F.wave, NGW = F.G * NWAVES;
    for (int m = gw; m < M; m += NGW) {
        const GAS v4u* p1 = (const GAS v4u*)(O1 + (size_t)m * 1024 + 16 * F.lane); const GAS v4u* p2 = (const GAS v4u*)(O2 + (size_t)m * 1024 + 16 * F.lane);
        const v4u a0 = p1[0], a1 = p1[1], b0 = p2[0], b1 = p2[1];
        const unsigned aw[8] = {a0.x, a0.y, a0.z, a0.w, a1.x, a1.y, a1.z, a1.w}, bw[8] = {b0.x, b0.y, b0.z, b0.w, b1.x, b1.y, b1.z, b1.w};
        float d[16]; float ss = 0.f;
#pragma unroll
        for (int i = 0; i < 8; ++i) { d[2 * i] = __uint_as_float(aw[i] << 16) - lam * __uint_as_float(bw[i] << 16); d[2 * i + 1] = __uint_as_float(aw[i] & 0xffff0000u) - lam * __uint_as_float(bw[i] & 0xffff0000u);
            ss += d[2 * i] * d[2 * i] + d[2 * i + 1] * d[2 * i + 1]; }
        ss += __shfl_xor(ss, 1); ss += __shfl_xor(ss, 2); ss += __shfl_xor(ss, 4);
        const float rstd = 1.0f / sqrtf(ss * (1.f / 128.f) + RMS_EPS);
        v4u o0, o1;
        o0.x = pk2(d[0] * rstd * gd[0], d[1] * rstd * gd[1]); o0.y = pk2(d[2] * rstd * gd[2], d[3] * rstd * gd[3]); o0.z = pk2(d[4] * rstd * gd[4], d[5] * rstd * gd[5]); o0.w = pk2(d[6] * rstd * gd[6], d[7] * rstd * gd[7]);
        o1.x = pk2(d[8] * rstd * gd[8], d[9] * rstd * gd[9]); o1.y = pk2(d[10] * rstd * gd[10], d[11] * rstd * gd[11]); o1.z = pk2(d[12] * rstd * gd[12], d[13] * rstd * gd[13]); o1.w = pk2(d[14] * rstd * gd[14], d[15] * rstd * gd[15]);
        GAS v4u* po = (GAS v4u*)(MIX + (size_t)m * 2048 + 16 * F.lane); po[0] = o0; po[1] = o1;
    }
}

__global__ void __launch_bounds__(NWAVES * 64, 2) mega_fwd(Args args) {
    extern __shared__ __attribute__((aligned(16))) unsigned char lds[];
    Frame F;
    F.lds = (LAS unsigned char*)lds;
    F.MISC = (volatile LAS unsigned*)(F.lds + MISC_OFF);
    F.tid = threadIdx.x; F.lane = 0; F.wave = 0;
    F.G = gridDim.x; { const int bx = blockIdx.x; F.vcu = (F.G % 8 == 0) ? (bx % 8) * (F.G / 8) + bx / 8 : bx; }
    unsigned char* ws = args.ws;
    F.ctl = (gu32*)(ws + WS_CTL);
    for (int u = F.tid; u < (LDS_BYTES - LDSCTL_OFF) / 4; u += NWAVES * 64) ((LAS unsigned*)(F.lds + LDSCTL_OFF))[u] = 0u;
    __syncthreads();
    XcdBarrier bar = xcd_barrier_post((unsigned*)(F.ctl + CW_BAR), F.MISC + 8);
    const int lo = args.ph_lo, hi = args.ph_hi;
#define IN(k) (lo <= (k) && (k) < hi)
#define FRESH(Fk) Frame Fk = F; asm volatile("" : "+v"(Fk.tid)); Fk.lane = Fk.tid & 63; Fk.wave = __builtin_amdgcn_readfirstlane(Fk.tid >> 6)
#define BOTH(k) (IN(k) && IN((k) + 1))
    bf16 *XN = (bf16*)(ws + WS_XN), *Win_t = (bf16*)(ws + WS_WIN);

    if (IN(0)) { FRESH(F0); p0_prologue(F0, args); if (BOTH(0)) xcd_barrier(bar); }
    if (IN(1)) { FRESH(F1); p1_norm(F1, args); if (BOTH(1)) xcd_barrier(bar); }
    if (IN(2)) {
        pg8::Gemm g{XN, Win_t, M, NPROJ_PAD, DM}; pg8::StaticOrder S; S.init(M, NPROJ_PAD, F.G, (int)blockIdx.x);
        pg8::EpiProj E{(bf16*)(ws + WS_QD), (bf16*)(ws + WS_KD), (bf16*)(ws + WS_VD), (bf16*)(ws + WS_QS), (bf16*)(ws + WS_KS), (bf16*)(ws + WS_VS), (bf16*)(ws + WS_QI), (bf16*)(ws + WS_KI), (float*)(ws + WS_WI), (const float*)(ws + WS_ROPE), ws + WS_KS8, ws + WS_VS8};
        pg8::gemm_phase<pg8::EpiProj, pg8::StaticOrder, true, true>(F.lds + RING_OFF, g, S, E);
        if (F.G == 256 && (int)blockIdx.x >= P2_IDLE_FIRST) {
            FRESH(F2);
            LAS float* scr2 = (LAS float*)(F2.lds + RING_OFF + F2.wave * 16384);
            const int base = (((int)blockIdx.x - P2_IDLE_FIRST) * NWAVES + F2.wave) * P2_IDLE_PER_WAVE;
            for (int j = 0; j < P2_IDLE_PER_WAVE; ++j) ffn_transpose_item((const float*)args.in[16], (const float*)args.in[17], (const float*)args.in[18], (bf16*)(ws + WS_WGU), (bf16*)(ws + WS_WD), scr2, base + j, F2.lane);
        }
        if (BOTH(2)) xcd_barrier(bar);
    }
    if (IN(3)) {
        static_assert(attn_body::ATTN_LDS_BYTES <= RING_BYTES, "attention LDS");
        const attn_body::AttnTensors AT{(const attn_body::bf16*)(ws + WS_QD), (const attn_body::bf16*)(ws + WS_KD), (const attn_body::bf16*)(ws + WS_VD), (attn_body::bf16*)(ws + WS_O1), (attn_body::bf16*)(ws + WS_O2)};
        const attn_body::StaticOrder S((int)F.G, F.vcu);
        attn_body::attn_phase<attn_body::StaticOrder>((char*)lds + RING_OFF, AT, S);
        if (BOTH(3)) xcd_barrier(bar);
    }
    if (IN(4)) {
        static_assert(dsa_body::L_TOTAL <= RING_BYTES, "dsa LDS");
        const dsa_body::DsaTensors DT{(const bf16*)(ws + WS_QI), (const bf16*)(ws + WS_KI), (const float*)(ws + WS_WI), (const bf16*)(ws + WS_QS), (const bf16*)(ws + WS_KS), (const bf16*)(ws + WS_VS), (bf16*)(ws + WS_MIX), (float*)(ws + WS_SCORES), ws + WS_KS8, ws + WS_VS8};
        FRESH(F4);
#ifndef NO_DSA
        const FfnHook hook{(const float*)args.in[16], (const float*)args.in[17], (const float*)args.in[18], (bf16*)(ws + WS_WGU), (bf16*)(ws + WS_WD), F4.vcu * NWAVES + F4.wave, F4.G * NWAVES};
        dsa_body::dsa_phase(F4.lds + RING_OFF, DT, F4.vcu, F4.G, F4.tid, F4.wave, F4.lane, hook);
#endif
#ifndef NO_COMBINE
        p4_combine(F4, args);
#endif
        if (BOTH(4)) xcd_barrier(bar);
    }
    if (IN(5)) {
        pg8::Gemm g{(bf16*)(ws + WS_MIX), (bf16*)(ws + WS_WO), M, DM, DM}; pg8::StaticOrder S; S.init(M, DM, F.G, (int)blockIdx.x);
        pg8::EpiBf16P E{(bf16*)(ws + WS_MIXOUT), DM};
        pg8::gemm_phase<pg8::EpiBf16P, pg8::StaticOrder, true, true>(F.lds + RING_OFF, g, S, E);
        if (BOTH(5)) xcd_barrier(bar);
    }
    if (IN(6)) { FRESH(F6); p6_post1(F6, args); if (BOTH(6)) xcd_barrier(bar); }
    if (IN(7)) {
        pg8::Gemm g{XN, (bf16*)(ws + WS_WGU), M, 2 * FF, DM}; pg8::StaticOrder S; S.init(M, 2 * FF, F.G, (int)blockIdx.x);
        pg8::EpiSwi E{(bf16*)(ws + WS_ACT), FF};
        pg8::gemm_phase<pg8::EpiSwi, pg8::StaticOrder, true, true>(F.lds + RING_OFF, g, S, E);
        if (F.G == 256 && (int)blockIdx.x >= 128) {
            FRESH(F7);
            LAS float* scr7 = (LAS float*)(F7.lds + RING_OFF + F7.wave * 16384);
            const int w7 = ((int)blockIdx.x - 128) * NWAVES + F7.wave;
            for (int it = 2 * I_FG + w7; it < N_FFN_ITEMS; it += 128 * NWAVES) ffn_transpose_item((const float*)args.in[16], (const float*)args.in[17], (const float*)args.in[18], (bf16*)(ws + WS_WGU), (bf16*)(ws + WS_WD), scr7, it, F7.lane);
        }
        if (BOTH(7)) xcd_barrier(bar);
    }
    if (IN(8)) {
        pg8::Gemm g{(bf16*)(ws + WS_ACT), (bf16*)(ws + WS_WD), M, DM, FF}; pg8::StaticOrder S; S.init(M, DM, F.G, (int)blockIdx.x);
        pg8::EpiBf16P E{(bf16*)(ws + WS_FFO), DM};
        pg8::gemm_phase<pg8::EpiBf16P, pg8::StaticOrder, true, true>(F.lds + RING_OFF, g, S, E);
        if (BOTH(8)) xcd_barrier(bar);
    }
    if (IN(9)) { FRESH(F9); p9_post2(F9, args); }
#undef IN
#undef BOTH
}

extern "C" void kernel_launch(void* const* d_in, const int* in_sizes, int n_in, void* d_out, int out_size, void* d_ws, size_t ws_size, hipStream_t stream) {
    static int grid = 0;
    if (grid == 0) {
        if (n_in != 19 || in_sizes[0] != M * DM || out_size != M * DM || ws_size < WS_END) { fprintf(stderr, "kernel_launch: built for 19 inputs, x and out of %d floats, >= %zu bytes of workspace; got n_in %d, out %d, ws %zu; nothing launched\n", M * DM, (size_t)WS_END, n_in, out_size, ws_size); grid = -1; return; }
        int dev = 0, cus = 0, per_cu = 0;
        if (hipGetDevice(&dev) != hipSuccess || hipDeviceGetAttribute(&cus, hipDeviceAttributeMultiprocessorCount, dev) != hipSuccess) { fprintf(stderr, "kernel_launch: hipGetDevice / hipDeviceGetAttribute failed; nothing launched\n"); grid = -1; return; }
        if (hipFuncSetAttribute((const void*)mega_fwd, hipFuncAttributeMaxDynamicSharedMemorySize, LDS_BYTES) != hipSuccess) { fprintf(stderr, "kernel_launch: hipFuncSetAttribute failed (%d bytes of dynamic LDS per workgroup); nothing launched\n", LDS_BYTES); grid = -1; return; }
        if (hipOccupancyMaxActiveBlocksPerMultiprocessor(&per_cu, (const void*)mega_fwd, NWAVES * 64, LDS_BYTES) != hipSuccess || per_cu < 1) fprintf(stderr, "kernel_launch: note: the occupancy query reports %d workgroups per CU\n", per_cu);
        (void)hipGetLastError();
        grid = cus;
    }
    if (grid < 0) return;
    if (hipMemsetAsync((char*)d_ws + WS_CTL, 0, CTL_ZERO_BYTES, stream) != hipSuccess) { fprintf(stderr, "kernel_launch: hipMemsetAsync of the control words failed; nothing launched\n"); return; }
    Args a{};
    for (int i = 0; i < 19; ++i) a.in[i] = d_in[i];
    a.out = (float*)d_out; a.ws = (unsigned char*)d_ws; a.ph_lo = 0; a.ph_hi = 10;
    hipLaunchKernelGGL(mega_fwd, dim3(grid), dim3(NWAVES * 64), LDS_BYTES, stream, a);
}
```

```cpp
#include <hip/hip_runtime.h>
#include <hip/hip_bf16.h>
#include <cstdio>
#include <cstdint>
#include <cmath>

constexpr int BATCH = 2, SEQ = 4096, DM = 2048, M = BATCH * SEQ, NPROJ = 5456, NPROJ_PAD = 5632, FF = 5632, NADA = 6 * DM;
constexpr float RMS_EPS = 1e-6f;
constexpr float LOG2E = 1.4426950408889634f;
constexpr float C2D = 0.125f * LOG2E;
constexpr float C2S = 0.08838834764831845f * LOG2E;
constexpr float IDXW_SCALE = 0.03125f;
constexpr int ADA_KC = 16;

constexpr size_t MiB = 1u << 20;
constexpr size_t WS_CTL = 0, CTL_ZERO_BYTES = 64 * 1024, WS_MODP = 1 * MiB, WS_MOD = 3 * MiB, WS_ROPE = 4 * MiB, WS_WI = 6 * MiB, WS_KI = 7 * MiB, WS_KS = 8 * MiB, WS_VS = 10 * MiB, WS_KS8 = 12 * MiB, WS_VS8 = 13 * MiB;
constexpr size_t WS_WIN = 16 * MiB, WS_WO = 38 * MiB, WS_WGU = 46 * MiB, WS_WD = 90 * MiB;
constexpr size_t WS_MIX = 112 * MiB, WS_QD = 144 * MiB, WS_KD = 160 * MiB, WS_VD = 176 * MiB, WS_QS = 192 * MiB, WS_QI = 208 * MiB, WS_O1 = 224 * MiB, WS_O2 = 240 * MiB;
constexpr size_t WS_XN = 256 * MiB, WS_SCORES = 256 * MiB, WS_MIXOUT = 288 * MiB, WS_FFO = 288 * MiB, WS_ACT = 144 * MiB, WS_END = 384 * MiB;
constexpr int CW_TMO = 0, CW_CODE = 1, CW_BAR = 4096;
#define GAS __attribute__((address_space(1)))
#define LAS __attribute__((address_space(3)))
typedef unsigned short bf16;
typedef unsigned v4u __attribute__((ext_vector_type(4)));
typedef float f32x4 __attribute__((ext_vector_type(4)));
typedef short bf16x8 __attribute__((ext_vector_type(8)));
typedef GAS unsigned gu32;
typedef GAS unsigned long long gu64;
#define RLX_AGENT __ATOMIC_RELAXED, __HIP_MEMORY_SCOPE_AGENT
#define LDS_WAIT() asm volatile("s_waitcnt lgkmcnt(0)" ::: "memory")
#define VM_WAIT() asm volatile("s_waitcnt vmcnt(0)" ::: "memory")
__device__ __forceinline__ unsigned long long rt() { return __builtin_amdgcn_s_memrealtime(); }
__device__ __forceinline__ unsigned f2bf(float f) { unsigned u = __builtin_bit_cast(unsigned, f); return (u + 0x7fffu + ((u >> 16) & 1u)) >> 16; }
__device__ __forceinline__ unsigned pk2(float lo, float hi) { return f2bf(lo) | (f2bf(hi) << 16); }

#define XB_TMO      128
#define XB_XCNT(j)  (256  + 64 * (j))
#define XB_XSUB(j)  (1280 + 64 * (j))
#define XB_XGEN(j)  (2304 + 64 * (j))
#define XB_TOP      3328
#define XB_TOPGEN   3392
#define XCD_BAR_WORDS 3456
#define XB_SPIN_CAP (1u << 18)

__device__ __forceinline__ unsigned xb_ld(unsigned* p)              { return __hip_atomic_load(p, __ATOMIC_RELAXED, __HIP_MEMORY_SCOPE_AGENT); }
__device__ __forceinline__ unsigned xb_add(unsigned* p, unsigned v) { return __hip_atomic_fetch_add(p, v, __ATOMIC_RELAXED, __HIP_MEMORY_SCOPE_AGENT); }
__device__ __forceinline__ unsigned xb_xcc_id() { return (unsigned)__builtin_amdgcn_s_getreg((3 << 11) | 20) & 0xFu; }
#define XB_SPIN(cond, bar) do { unsigned _sp = 0; while (cond) { __builtin_amdgcn_s_sleep(1); \
    if ((++_sp & 255u) == 0u) { if (xb_ld(&(bar)[XB_TMO])) break; if (_sp > XB_SPIN_CAP) { atomicAdd(&(bar)[XB_TMO], 1u); break; } } } } while (0)

struct XcdBarrier {
    unsigned* bar; unsigned x;
    volatile LAS unsigned* st;
};

__device__ __forceinline__ XcdBarrier xcd_barrier_post(unsigned* bar, volatile LAS unsigned* st) {
    XcdBarrier b; b.bar = bar; b.x = xb_xcc_id(); b.st = st;
    if (threadIdx.x == 0) (void)xb_add(&bar[XB_XCNT(b.x)], 1u);
    return b;
}
__device__ __forceinline__ void xcd_barrier_complete(unsigned* bar, unsigned x, unsigned& nloc, unsigned& nx) {
    const unsigned G = gridDim.x * gridDim.y * gridDim.z;
    unsigned sum, cnt, mine, sp = 0u;
    for (;;) {
        sum = 0u; cnt = 0u; mine = 0u;
#pragma unroll
        for (unsigned j = 0; j < 16; ++j) { const unsigned c = xb_ld(&bar[XB_XCNT(j)]); sum += c; cnt += (c > 0u) ? 1u : 0u; mine = (j == x) ? c : mine; }
        if (sum == G) break;
        __builtin_amdgcn_s_sleep(1);
        if ((++sp & 255u) == 0u) { if (xb_ld(&bar[XB_TMO])) break; if (sp > XB_SPIN_CAP) { atomicAdd(&bar[XB_TMO], 1u); break; } }
    }
    nloc = mine > 0u ? mine : 1u; nx = cnt > 0u ? cnt : 1u;
}

__device__ __forceinline__ void xcd_barrier(const XcdBarrier& b) {
    asm volatile("s_waitcnt vmcnt(0)" ::: "memory");
    __syncthreads();
    if (threadIdx.x == 0) {
        unsigned* bar = b.bar;
        __builtin_amdgcn_s_waitcnt(0);
        unsigned nloc = b.st[0], nx = b.st[1];
        if (nloc == 0u) { xcd_barrier_complete(bar, b.x, nloc, nx); b.st[0] = nloc; b.st[1] = nx; }
        const unsigned old = xb_add(&bar[XB_XSUB(b.x)], 1u);
        const unsigned gen = old / nloc;
        if (old + 1u == (gen + 1u) * nloc) {
            __builtin_amdgcn_fence(__ATOMIC_RELEASE, "agent");
            asm volatile("s_waitcnt vmcnt(0)" ::: "memory");
            const unsigned og = xb_add(&bar[XB_TOP], 1u);
            const unsigned tg = og / nx;
            if (og + 1u == (tg + 1u) * nx) xb_add(&bar[XB_TOPGEN], 1u);
            else XB_SPIN(xb_ld(&bar[XB_TOPGEN]) == tg, bar);
            __builtin_amdgcn_fence(__ATOMIC_ACQUIRE, "agent");
            xb_add(&bar[XB_XGEN(b.x)], 1u);
            asm volatile("s_waitcnt vmcnt(0)" ::: "memory");
        } else {
            XB_SPIN(xb_ld(&bar[XB_XGEN(b.x)]) == gen, bar);
            __builtin_amdgcn_fence(__ATOMIC_ACQUIRE, "agent");
            asm volatile("s_waitcnt vmcnt(0)" ::: "memory");
        }
    }
    __syncthreads();
}
namespace pg8 {
#define PG8_LAS __attribute__((address_space(3)))
typedef unsigned short bf16_t;
typedef short bf16x8 __attribute__((ext_vector_type(8)));
typedef float f32x4 __attribute__((ext_vector_type(4)));
typedef unsigned u32x4 __attribute__((ext_vector_type(4)));
constexpr int BM = 256, BK = 64, HALF = 128, HTB = HALF * BK * 2  , STAGE_BYTES = 8 * HTB, NXCD = 8, WGM = 8;

__host__ __device__ __forceinline__ int lds_byte(int r, int c) { const int st = (r >> 4) * 2 + (c >> 5), rr = r & 15, cc = c & 31, ob = rr * 64 + cc * 2; return st * 1024 + (ob ^ (((ob >> 9) & 1) << 5)); }
__host__ __device__ __forceinline__ void stage_rc(int b, int& R, int& C) { const int st = b / 1024, sb = b % 1024, swz = sb ^ (((sb >> 9) & 1) << 5); R = (st >> 1) * 16 + swz / 64; C = (st & 1) * 32 + (swz % 64) / 2; }
__host__ __device__ __forceinline__ int perm32(int rho) { const int n = rho >> 4, i = rho & 15; return 8 * (i >> 2) + 4 * n + (i & 3); }

struct Unit { int pm, pn; };
struct Gemm { const bf16_t* A; const bf16_t* Bt; int M, N, K; };

struct StaticOrder {
    int nM, nN, nwg, G, c;
    __host__ __device__ void init(int M, int N, int G_, int c_) { nM = M / BM; nN = N / BM; nwg = nM * nN; G = G_; c = c_; }
    __host__ __device__ bool next(int i, Unit& u) const {
        const long L = (long)i * G + c; if (L >= nwg) return false;
        int wgid = (int)L; { const int q = nwg / NXCD, r = nwg % NXCD, xcd = wgid % NXCD, off = wgid / NXCD; wgid = (xcd < r ? xcd * (q + 1) : r * (q + 1) + (xcd - r) * q) + off; }
        const int nig = WGM * nN, gid = wgid / nig, fm = gid * WGM, gsz = (nM - fm) < WGM ? (nM - fm) : WGM;
        u.pm = fm + ((wgid % nig) % gsz); u.pn = (wgid % nig) / gsz; return true;
    }
    __device__ __forceinline__ void a_ready(const Unit&) const {}
    __device__ __forceinline__ void done(const Unit&) const {}
};

__device__ __forceinline__ unsigned cvt_pk_bf16(float lo, float hi) { unsigned r; asm volatile("v_cvt_pk_bf16_f32 %0, %1, %2" : "=v"(r) : "v"(lo), "v"(hi)); return r; }
typedef float f32x2 __attribute__((ext_vector_type(2)));
#define PG8_GAS __attribute__((address_space(1)))
typedef unsigned u32x2 __attribute__((ext_vector_type(2)));
__device__ __forceinline__ u32x4 pack8(f32x4 v0, f32x4 v1, float sc) {
    u32x4 w; w.x = cvt_pk_bf16(v0[0] * sc, v0[1] * sc); w.y = cvt_pk_bf16(v0[2] * sc, v0[3] * sc); w.z = cvt_pk_bf16(v1[0] * sc, v1[1] * sc); w.w = cvt_pk_bf16(v1[2] * sc, v1[3] * sc); return w; }
__device__ __forceinline__ f32x4 shx4(f32x4 v, int mask) { f32x4 r; r[0] = __shfl_xor(v[0], mask); r[1] = __shfl_xor(v[1], mask); r[2] = __shfl_xor(v[2], mask); r[3] = __shfl_xor(v[3], mask); return r; }

struct EpiF32 {
    static constexpr bool PERM = false, AFTER_DRAIN = false;
    float* out; int ldc;
    __device__ __forceinline__ void operator()(const f32x4 (&acc)[2][2][4][2], const Unit& u, int wr, int wc, int fr, int fq) const {
        const int row0 = u.pm * BM + wr * 64 + fr, col0 = u.pn * BM + wc * 32 + 4 * fq;
#pragma unroll
        for (int ai = 0; ai < 2; ++ai)
#pragma unroll
            for (int m = 0; m < 4; ++m) { float* rowp = out + (size_t)(row0 + ai * HALF + m * 16) * ldc + col0;
#pragma unroll
                for (int bj = 0; bj < 2; ++bj)
#pragma unroll
                    for (int n = 0; n < 2; ++n) *(PG8_GAS f32x4*)(rowp + bj * HALF + n * 16) = acc[ai][bj][m][n]; }
    }
};
struct EpiBf16P {
    static constexpr bool PERM = true, AFTER_DRAIN = false;
    bf16_t* out; int ldc;
    __device__ __forceinline__ void operator()(const f32x4 (&acc)[2][2][4][2], const Unit& u, int wr, int wc, int fr, int fq) const {
        const int row0 = u.pm * BM + wr * 64 + fr, col0 = u.pn * BM + wc * 32 + 8 * fq;
#pragma unroll
        for (int ai = 0; ai < 2; ++ai)
#pragma unroll
            for (int m = 0; m < 4; ++m) { bf16_t* rowp = out + (size_t)(row0 + ai * HALF + m * 16) * ldc + col0;
#pragma unroll
                for (int bj = 0; bj < 2; ++bj) *(PG8_GAS u32x4*)(rowp + bj * HALF) = pack8(acc[ai][bj][m][0], acc[ai][bj][m][1], 1.0f); }
    }
};
__device__ __forceinline__ float silu_mul(float g, float uu) { return g * uu * __builtin_amdgcn_rcpf(1.0f + __builtin_amdgcn_exp2f(-1.4426950408889634f * g)); }
struct EpiSwi {
    static constexpr bool PERM = true, AFTER_DRAIN = false;
    bf16_t* out; int ldc;
    __device__ __forceinline__ void operator()(const f32x4 (&acc)[2][2][4][2], const Unit& u, int wr, int wc, int fr, int fq) const {
        const int row0 = u.pm * BM + wr * 64 + fr, col0 = u.pn * HALF + wc * 32 + 8 * fq;
#pragma unroll
        for (int ai = 0; ai < 2; ++ai)
#pragma unroll
            for (int m = 0; m < 4; ++m) {
                const f32x4 g0 = acc[ai][0][m][0], g1 = acc[ai][0][m][1], u0 = acc[ai][1][m][0], u1 = acc[ai][1][m][1];
                f32x4 a, b;
#pragma unroll
                for (int e = 0; e < 4; ++e) { a[e] = silu_mul(g0[e], u0[e]); b[e] = silu_mul(g1[e], u1[e]); }
                *(PG8_GAS u32x4*)(out + (size_t)(row0 + ai * HALF + m * 16) * ldc + col0) = pack8(a, b, 1.0f);
            }
    }
};
struct EpiProj {
    static constexpr bool PERM = true, AFTER_DRAIN = false;
    bf16_t *Qd, *Kd, *Vd, *Qs, *Ks, *Vs, *Qi, *Ki; float* Wi; const float* rope; unsigned char *Ks8, *Vs8;
    __device__ __forceinline__ void operator()(const f32x4 (&acc)[2][2][4][2], const Unit& u, int wr, int wc, int fr, int fq) const {
        const int pn = u.pn;
        const int row0 = u.pm * BM + wr * 64 + fr;
        bf16_t* base[2]; int pitch, colh[2], kind[2], ncol; float sc = 1.0f;
        if (pn < 4)       { base[0] = base[1] = Qd; pitch = 1024; colh[0] = pn * 256; colh[1] = colh[0] + 128; kind[0] = kind[1] = 1; sc = C2D; ncol = 128; }
        else if (pn < 8)  { base[0] = base[1] = Kd; pitch = 1024; colh[0] = (pn - 4) * 256; colh[1] = colh[0] + 128; kind[0] = kind[1] = 1; ncol = 128; }
        else if (pn < 12) { base[0] = base[1] = Vd; pitch = 1024; colh[0] = (pn - 8) * 256; colh[1] = colh[0] + 128; kind[0] = kind[1] = 0; ncol = 128; }
        else if (pn < 16) { base[0] = base[1] = Qs; pitch = 1024; colh[0] = (pn - 12) * 256; colh[1] = colh[0] + 128; kind[0] = kind[1] = 2; sc = C2S; ncol = 128; }
        else if (pn == 16){ base[0] = Ks; base[1] = Vs; pitch = 128; colh[0] = colh[1] = 0; kind[0] = 2; kind[1] = 0; ncol = 128; }
        else if (pn < 21) { base[0] = base[1] = Qi; pitch = 1024; colh[0] = (pn - 17) * 256; colh[1] = colh[0] + 128; kind[0] = kind[1] = 1; ncol = 128; }
        else              { base[0] = Ki; base[1] = nullptr; pitch = 64; colh[0] = colh[1] = 0; kind[0] = 1; kind[1] = 0; ncol = 64; }
        const int cl = wc * 32 + 8 * fq;
        const bool do16 = ((wc & 1) == 0) && (wc * 32 < ncol), do32 = (wc == 0);
#pragma unroll
        for (int ai = 0; ai < 2; ++ai)
#pragma unroll
            for (int m = 0; m < 4; ++m) {
                const int row = row0 + ai * HALF + m * 16;
                const float* rp = rope + (size_t)row * 48;
#pragma unroll
                for (int bj = 0; bj < 2; ++bj) {
                    f32x4 v0 = acc[ai][bj][m][0], v1 = acc[ai][bj][m][1];
                    if (kind[bj] == 1 && do16) {
                        const f32x4 p0 = shx4(v0, 16), p1 = shx4(v1, 16);
                        if (fq < 2) {
                            const f32x4 c0 = *(const PG8_GAS f32x4*)(rp), c1 = *(const PG8_GAS f32x4*)(rp + 4), s0 = *(const PG8_GAS f32x4*)(rp + 8), s1 = *(const PG8_GAS f32x4*)(rp + 12);
                            const float sg = fq == 0 ? -1.0f : 1.0f;
                            v0 = v0 * c0 + sg * (p0 * s0); v1 = v1 * c1 + sg * (p1 * s1);
                        }
                    } else if (kind[bj] == 2 && do32) {
                        const f32x4 p0 = shx4(v0, 32), p1 = shx4(v1, 32);
                        const int io = 8 * (fq & 1);
                        const f32x4 c0 = *(const PG8_GAS f32x4*)(rp + 16 + io), c1 = *(const PG8_GAS f32x4*)(rp + 20 + io), s0 = *(const PG8_GAS f32x4*)(rp + 32 + io), s1 = *(const PG8_GAS f32x4*)(rp + 36 + io);
                        const float sg = fq < 2 ? -1.0f : 1.0f;
                        v0 = v0 * c0 + sg * (p0 * s0); v1 = v1 * c1 + sg * (p1 * s1);
                    }
                    if (base[bj] != nullptr && cl < ncol) *(PG8_GAS u32x4*)(base[bj] + (size_t)row * pitch + colh[bj] + cl) = pack8(v0, v1, sc);
                    if (pn == 16) {
                        int lo = __builtin_amdgcn_cvt_pk_fp8_f32(v0[0], v0[1], 0, false); lo = __builtin_amdgcn_cvt_pk_fp8_f32(v0[2], v0[3], lo, true);
                        int hi = __builtin_amdgcn_cvt_pk_fp8_f32(v1[0], v1[1], 0, false); hi = __builtin_amdgcn_cvt_pk_fp8_f32(v1[2], v1[3], hi, true);
                        u32x2 w8; w8.x = (unsigned)lo; w8.y = (unsigned)hi;
                        *(PG8_GAS u32x2*)((bj ? Vs8 : Ks8) + (size_t)row * 128 + cl) = w8;
                    }
                    if (pn == 21 && bj == 0 && wc == 2 && fq < 2) { float* wp = Wi + (size_t)row * 16 + 8 * fq; *(PG8_GAS f32x4*)wp = v0 * IDXW_SCALE; *(PG8_GAS f32x4*)(wp + 4) = v1 * IDXW_SCALE; }
                }
            }
    }
};
template <class Epi, class Sched, bool ALIGN_EPI = false, bool SP2 = false>
__device__ __forceinline__ void gemm_phase(PG8_LAS unsigned char* lds, const Gemm g, const Sched& S, const Epi& E) {
    const int tid = threadIdx.x, wid = __builtin_amdgcn_readfirstlane(tid >> 6), lane = tid & 63, wr = wid >> 2, wc = wid & 3, fr = lane & 15, fq = lane >> 4;
    const int K = g.K, nt = K / BK;
    unsigned voffA[2], voffB[2];
#pragma unroll
    for (int i = 0; i < 2; ++i) { int R, C; stage_rc(tid * 16 + i * 8192, R, C); const int Rb = Epi::PERM ? ((R & ~31) + perm32(R & 31)) : R;
        voffA[i] = (unsigned)(R * K + C) * 2u; voffB[i] = (unsigned)(Rb * K + C) * 2u; }
    const size_t kstep = (size_t)(BK * 2);
    const size_t hstep = (size_t)HALF * K * 2;
    const size_t tstep = 2 * hstep;
    const unsigned ldsw = (unsigned)wid * 1024u;
    const int aoff = lds_byte(wr * 64 + fr, fq * 8), boff = lds_byte(wc * 32 + fr, fq * 8);
#define PG8_SA(b, h) (((b) * 2 + (h)) * HTB)
#define PG8_SB(b, h) ((4 + (b) * 2 + (h)) * HTB)
#define PG8_STAGE(bufoff, gbase, voff) do { _Pragma("unroll") for (int _i = 0; _i < 2; ++_i) \
        __builtin_amdgcn_global_load_lds((const unsigned*)((const char*)(gbase) + (voff)[_i]), (PG8_LAS unsigned*)(lds + (bufoff) + ldsw + _i * 8192), 16, 0, 0); } while (0)
#define PG8_LDA(dst, b, h) do { _Pragma("unroll") for (int m = 0; m < 4; ++m) _Pragma("unroll") for (int k = 0; k < 2; ++k) dst[m][k] = *(const PG8_LAS bf16x8*)(lds + PG8_SA(b, h) + aoff + m * 2048 + k * 1024); } while (0)
#define PG8_LDB(dst, b, h) do { _Pragma("unroll") for (int n = 0; n < 2; ++n) _Pragma("unroll") for (int k = 0; k < 2; ++k) dst[n][k] = *(const PG8_LAS bf16x8*)(lds + PG8_SB(b, h) + boff + n * 2048 + k * 1024); } while (0)
#define PG8_MMA(ai, bj, At, Bt) do { __builtin_amdgcn_s_setprio(1); _Pragma("unroll") for (int m = 0; m < 4; ++m) _Pragma("unroll") for (int n = 0; n < 2; ++n) _Pragma("unroll") for (int k = 0; k < 2; ++k) \
        acc[ai][bj][m][n] = __builtin_amdgcn_mfma_f32_16x16x32_bf16(Bt[n][k], At[m][k], acc[ai][bj][m][n], 0, 0, 0); __builtin_amdgcn_s_setprio(0); } while (0)
#define PG8_WAIT_V(n) asm volatile("s_waitcnt vmcnt(" #n ")" ::: "memory")
#define PG8_WAIT_L(n) asm volatile("s_waitcnt lgkmcnt(" #n ")" ::: "memory")
#define PG8_BAR __builtin_amdgcn_s_barrier()
#define PG8_SCHED __builtin_amdgcn_sched_barrier(0)
    Unit cur, nxt; int ui = 0;
    if (!S.next(0, cur)) return;
    f32x4 acc[2][2][4][2];
#pragma unroll
    for (int a = 0; a < 2; ++a)
#pragma unroll
        for (int b = 0; b < 2; ++b)
#pragma unroll
            for (int m = 0; m < 4; ++m)
#pragma unroll
                for (int n = 0; n < 2; ++n) acc[a][b][m][n] = (f32x4){0.f, 0.f, 0.f, 0.f};
    bf16x8 At[4][2], B0[2][2], B1[2][2];
    const char* cA = (const char*)g.A + (size_t)cur.pm * tstep; const char* cB = (const char*)g.Bt + (size_t)cur.pn * tstep;
    S.a_ready(cur);
    if constexpr (SP2) {
        PG8_STAGE(PG8_SB(0, 0), cB, voffB); PG8_STAGE(PG8_SB(0, 1), cB + hstep, voffB); PG8_STAGE(PG8_SA(0, 0), cA, voffA); PG8_STAGE(PG8_SA(0, 1), cA + hstep, voffA);
        if (wr == 1) PG8_BAR;
        PG8_WAIT_V(2); PG8_BAR;
        PG8_STAGE(PG8_SB(1, 0), cB + kstep, voffB); PG8_STAGE(PG8_SA(1, 0), cA + kstep, voffA); PG8_STAGE(PG8_SB(1, 1), cB + hstep + kstep, voffB);
        PG8_WAIT_V(6); PG8_BAR;
    } else {
        PG8_STAGE(PG8_SB(0, 0), cB, voffB); PG8_STAGE(PG8_SA(0, 0), cA, voffA); PG8_STAGE(PG8_SB(0, 1), cB + hstep, voffB); PG8_STAGE(PG8_SA(0, 1), cA + hstep, voffA);
        if (wr == 1) PG8_BAR;
        PG8_WAIT_V(4); PG8_BAR;
        PG8_STAGE(PG8_SB(1, 0), cB + kstep, voffB); PG8_STAGE(PG8_SA(1, 0), cA + kstep, voffA); PG8_STAGE(PG8_SB(1, 1), cB + hstep + kstep, voffB);
        PG8_WAIT_V(6); PG8_BAR;
    }
    for (;;) {
        const bool has_next = S.next(ui + 1, nxt);
        const char* nA = has_next ? (const char*)g.A + (size_t)nxt.pm * tstep : cA; const char* nB = has_next ? (const char*)g.Bt + (size_t)nxt.pn * tstep : cB;
        for (int t = 0; t < nt; t += 2) {
            const bool last = (t == nt - 2);
            const char* a1 = cA + (size_t)(t + 1) * kstep;
            const char* a2 = last ? nA : cA + (size_t)(t + 2) * kstep; const char* b2 = last ? nB : cB + (size_t)(t + 2) * kstep;
            const char* a3 = a2 + kstep; const char* b3 = b2 + kstep;
            if (last && has_next) S.a_ready(nxt);
            if constexpr (SP2) {
            PG8_LDB(B0, 0, 0); PG8_LDB(B1, 0, 1); PG8_SCHED; PG8_LDA(At, 0, 0); PG8_STAGE(PG8_SA(1, 1), a1 + hstep, voffA);
            PG8_WAIT_V(8); PG8_WAIT_L(0); PG8_BAR; PG8_MMA(0, 0, At, B0); PG8_MMA(0, 1, At, B1); PG8_BAR; PG8_SCHED;
            PG8_LDA(At, 0, 1); PG8_STAGE(PG8_SB(0, 0), b2, voffB); PG8_STAGE(PG8_SB(0, 1), b2 + hstep, voffB); PG8_STAGE(PG8_SA(0, 0), a2, voffA);
            PG8_WAIT_V(8); PG8_WAIT_L(0); PG8_BAR; PG8_MMA(1, 0, At, B0); PG8_MMA(1, 1, At, B1); PG8_BAR; PG8_SCHED;
            PG8_LDB(B0, 1, 0); PG8_LDB(B1, 1, 1); PG8_SCHED; PG8_LDA(At, 1, 0); PG8_STAGE(PG8_SA(0, 1), a2 + hstep, voffA);
            PG8_WAIT_V(8); PG8_WAIT_L(0); PG8_BAR; PG8_MMA(0, 0, At, B0); PG8_MMA(0, 1, At, B1); PG8_BAR; PG8_SCHED;
            PG8_LDA(At, 1, 1); PG8_STAGE(PG8_SB(1, 0), b3, voffB); PG8_STAGE(PG8_SB(1, 1), b3 + hstep, voffB); PG8_STAGE(PG8_SA(1, 0), a3, voffA);
            PG8_WAIT_V(8); PG8_WAIT_L(0); PG8_BAR; PG8_MMA(1, 0, At, B0); PG8_MMA(1, 1, At, B1); PG8_BAR; PG8_SCHED;
            } else {
            PG8_LDB(B0, 0, 0); PG8_SCHED; PG8_LDA(At, 0, 0); PG8_STAGE(PG8_SA(1, 1), a1 + hstep, voffA);
            PG8_WAIT_L(8); PG8_BAR; PG8_WAIT_L(0); PG8_MMA(0, 0, At, B0); PG8_BAR; PG8_SCHED;
            PG8_LDB(B1, 0, 1); PG8_STAGE(PG8_SB(0, 0), b2, voffB);
            PG8_BAR; PG8_WAIT_L(0); PG8_MMA(0, 1, At, B1); PG8_BAR;
            PG8_LDA(At, 0, 1); PG8_STAGE(PG8_SA(0, 0), a2, voffA);
            PG8_BAR; PG8_WAIT_L(0); PG8_MMA(1, 0, At, B0); PG8_BAR; PG8_SCHED;
            PG8_STAGE(PG8_SB(0, 1), b2 + hstep, voffB);
            PG8_WAIT_V(6); PG8_BAR; PG8_MMA(1, 1, At, B1); PG8_BAR;
            PG8_LDB(B0, 1, 0); PG8_SCHED; PG8_LDA(At, 1, 0); PG8_STAGE(PG8_SA(0, 1), a2 + hstep, voffA);
            PG8_WAIT_L(8); PG8_BAR; PG8_WAIT_L(0); PG8_MMA(0, 0, At, B0); PG8_BAR; PG8_SCHED;
            PG8_LDB(B1, 1, 1); PG8_STAGE(PG8_SB(1, 0), b3, voffB);
            PG8_BAR; PG8_WAIT_L(0); PG8_MMA(0, 1, At, B1); PG8_BAR;
            PG8_LDA(At, 1, 1); PG8_STAGE(PG8_SA(1, 0), a3, voffA);
            PG8_BAR; PG8_WAIT_L(0); PG8_MMA(1, 0, At, B0); PG8_BAR; PG8_SCHED;
            PG8_STAGE(PG8_SB(1, 1), b3 + hstep, voffB);
            PG8_WAIT_V(6); PG8_BAR; PG8_MMA(1, 1, At, B1); PG8_BAR;
            }
        }
        if constexpr (ALIGN_EPI) { if (wr == 0) PG8_BAR; }
        if constexpr (!Epi::AFTER_DRAIN) { E(acc, cur, wr, wc, fr, fq); S.done(cur); }
        if (!has_next) break;
#pragma unroll
        for (int a = 0; a < 2; ++a)
#pragma unroll
            for (int b = 0; b < 2; ++b)
#pragma unroll
                for (int m = 0; m < 4; ++m)
#pragma unroll
                    for (int n = 0; n < 2; ++n) acc[a][b][m][n] = (f32x4){0.f, 0.f, 0.f, 0.f};
        cur = nxt; cA = nA; cB = nB; ++ui;
        if constexpr (ALIGN_EPI) { if (wr == 1) PG8_BAR; }
    }
    PG8_WAIT_V(0);
    if constexpr (!ALIGN_EPI) { if (wr == 0) PG8_BAR; }
    PG8_BAR;
    if constexpr (Epi::AFTER_DRAIN) { E.fused(acc, cur, wr, wc, fr, fq, lds, wid, lane); S.done(cur); }
#undef PG8_SA
#undef PG8_SB
#undef PG8_STAGE
#undef PG8_LDA
#undef PG8_LDB
#undef PG8_MMA
#undef PG8_WAIT_V
#undef PG8_WAIT_L
#undef PG8_BAR
#undef PG8_SCHED
}
}
namespace attn_body {
using bf16=__hip_bfloat16;
using bf16x8=__attribute__((ext_vector_type(8)))short;
using s16x4=__attribute__((ext_vector_type(4)))short;
using f32x16=__attribute__((ext_vector_type(16)))float;
using u32x4=__attribute__((ext_vector_type(4)))unsigned;
constexpr int SEQ=4096,D=64,DM=1024;
constexpr int NW=8,QBLK=32,QB=QBLK*NW,KVBLK=64,NQB=SEQ/QB;
constexpr int ATTN_PITCH=DM, ATTN_UNIT_ROWS=QB;
__device__ __forceinline__ int crow(int r,int hi){return (r&3)+8*(r>>2)+4*hi;}
#define SBAR() __builtin_amdgcn_sched_barrier(0)
__device__ __forceinline__ void cmask(f32x16&p0,f32x16&p1,int jb,int qrel,int hi){
  const float NEG=-INFINITY; int kb=64*jb+4*hi;
  #pragma unroll
  for(int r=0;r<16;++r){int kv=kb+(r&3)+8*(r>>2); if(kv>qrel)p0[r]=NEG; if(kv+32>qrel)p1[r]=NEG;}
}

constexpr int NSLOT=3, SLOTB=8192;
constexpr int LDS_K=0, LDS_V=NSLOT*SLOTB, LDS_WS=2*NSLOT*SLOTB, LDS_OST=LDS_WS+NW*64*4, LDS_BYTES=LDS_OST+NW*4096;
constexpr float C2=0.125f*1.4426950408889634f;
__device__ __forceinline__ void glds16(const void*gsrc,unsigned lds_dst){unsigned keep;
  asm volatile("s_mov_b32 %0, m0\n\ts_mov_b32 m0, %2\n\ts_nop 0\n\tglobal_load_lds_dwordx4 %1, off\n\ts_mov_b32 m0, %0":"=&s"(keep):"v"(gsrc),"s"(lds_dst):"memory");}
__device__ __forceinline__ float max3f(float a,float b,float c){float r;asm("v_max3_f32 %0, %1, %2, %3":"=v"(r):"v"(a),"v"(b),"v"(c));return r;}
__device__ __forceinline__ float max2f(float a,float b){float r;asm("v_max_f32_e32 %0, %1, %2":"=v"(r):"v"(a),"v"(b));return r;}
__device__ __forceinline__ float fadd_s(float a,float b){float r;asm("v_add_f32_e32 %0, %1, %2":"=v"(r):"v"(a),"v"(b));return r;}
__device__ __forceinline__ float fsub_s(float a,float b){float r;asm("v_sub_f32_e32 %0, %1, %2":"=v"(r):"v"(a),"v"(b));return r;}
typedef float f32x2_t __attribute__((ext_vector_type(2))); typedef __bf16 bf16x2_t __attribute__((ext_vector_type(2)));
__device__ __forceinline__ unsigned cvtpk_s(float lo,float hi){f32x2_t v={lo,hi};bf16x2_t b=__builtin_convertvector(v,bf16x2_t);return __builtin_bit_cast(unsigned,b);}
#define WAIT_BAR(N) asm volatile("s_waitcnt vmcnt(" #N ") lgkmcnt(0)\n\ts_barrier":::"memory")

__device__ __forceinline__ void qkt(f32x16&p0,f32x16&p1,const char*Kslot,const bf16x8*qr,const f32x16&negm,int r32,int hi){
  const char*kb=Kslot+hi*1024+r32*16;
  #pragma unroll
  for(int d0=0;d0<4;++d0){
    const bf16x8 b0=*reinterpret_cast<const bf16x8*>(kb+d0*2048);
    const bf16x8 b1=*reinterpret_cast<const bf16x8*>(kb+d0*2048+512);
    if(d0==0){p0=__builtin_amdgcn_mfma_f32_32x32x16_bf16(b0,qr[0],negm,0,0,0);p1=__builtin_amdgcn_mfma_f32_32x32x16_bf16(b1,qr[0],negm,0,0,0);}
    else{p0=__builtin_amdgcn_mfma_f32_32x32x16_bf16(b0,qr[d0],p0,0,0,0);p1=__builtin_amdgcn_mfma_f32_32x32x16_bf16(b1,qr[d0],p1,0,0,0);}}
}
typedef __attribute__((address_space(3))) const char* lds_cptr;
typedef short v4i16_t __attribute__((ext_vector_type(4)));
__device__ __forceinline__ void kload8(bf16x8*kf,lds_cptr kp){
  kf[0]=*(const __attribute__((address_space(3))) bf16x8*)(kp);      kf[1]=*(const __attribute__((address_space(3))) bf16x8*)(kp+512);
  kf[2]=*(const __attribute__((address_space(3))) bf16x8*)(kp+2048); kf[3]=*(const __attribute__((address_space(3))) bf16x8*)(kp+2560);
  kf[4]=*(const __attribute__((address_space(3))) bf16x8*)(kp+4096); kf[5]=*(const __attribute__((address_space(3))) bf16x8*)(kp+4608);
  kf[6]=*(const __attribute__((address_space(3))) bf16x8*)(kp+6144); kf[7]=*(const __attribute__((address_space(3))) bf16x8*)(kp+6656);
}
__device__ __forceinline__ void kload2(bf16x8*kf,lds_cptr kp,int j){ kf[2*j]=*(const __attribute__((address_space(3))) bf16x8*)(kp+j*2048); kf[2*j+1]=*(const __attribute__((address_space(3))) bf16x8*)(kp+j*2048+512); }
__device__ __forceinline__ s16x4 vtr(lds_cptr p){ return __builtin_bit_cast(s16x4,__builtin_amdgcn_ds_read_tr16_b64_v4i16((__attribute__((address_space(3))) v4i16_t*)p)); }
__device__ __forceinline__ float rowmax(const f32x16&p0,const f32x16&p1){
  float a=max3f(p0[0],p0[1],p1[0]),b=max3f(p0[2],p0[3],p1[1]);a=max3f(a,p1[2],p1[3]);
  #pragma unroll
  for(int r=4;r<16;r+=4){a=max3f(a,p0[r],p0[r+1]);b=max3f(b,p0[r+2],p0[r+3]);a=max3f(a,p1[r],p1[r+1]);b=max3f(b,p1[r+2],p1[r+3]);}
  const float m=max2f(a,b);
  auto rr=__builtin_amdgcn_permlane32_swap(__float_as_uint(m),__float_as_uint(m),false,false);
  return max2f(__uint_as_float(rr[0]),__uint_as_float(rr[1]));
}
__device__ __forceinline__ void pv(f32x16*o,int vb,bf16x8 pa0,bf16x8 pa1,bf16x8 pa2,bf16x8 pa3){
  #pragma unroll
  for(int d0=0;d0<2;++d0){s16x4 lo[4],hi[4];
    #pragma unroll
    for(int ks=0;ks<4;++ks){
      asm volatile("ds_read_b64_tr_b16 %0,%1 offset:%c2":"=&v"(lo[ks]):"v"(vb),"i"(d0*4096+ks*1024):"memory");
      asm volatile("ds_read_b64_tr_b16 %0,%1 offset:%c2":"=&v"(hi[ks]):"v"(vb),"i"(d0*4096+ks*1024+512):"memory");}
    asm volatile("s_waitcnt lgkmcnt(0)":::"memory");SBAR();
    #define PK(k) (bf16x8){lo[k][0],lo[k][1],lo[k][2],lo[k][3],hi[k][0],hi[k][1],hi[k][2],hi[k][3]}
    o[d0]=__builtin_amdgcn_mfma_f32_32x32x16_bf16(pa0,PK(0),o[d0],0,0,0);
    o[d0]=__builtin_amdgcn_mfma_f32_32x32x16_bf16(pa1,PK(1),o[d0],0,0,0);
    o[d0]=__builtin_amdgcn_mfma_f32_32x32x16_bf16(pa2,PK(2),o[d0],0,0,0);
    o[d0]=__builtin_amdgcn_mfma_f32_32x32x16_bf16(pa3,PK(3),o[d0],0,0,0);
    #undef PK
  }
}

#ifndef ATTN_STORE16
#define ATTN_STORE16(p,v) (*(u32x4*)(p)=(v))
#endif
template<int THRL> __device__ __forceinline__ void attn_unit(int b,int qcol,int vcol,int qb,const bf16*Q,const bf16*__restrict__ K,const bf16*__restrict__ V,bf16*O,char*shm){
  const int tid=threadIdx.x,lane=tid&63,r32=lane&31,hi=lane>>5; const int wid=__builtin_amdgcn_readfirstlane(tid>>6);
  const long rowbase=(long)b*SEQ; const int q0=qb*QB;
  const bf16*Qw=Q+(rowbase+q0+wid*QBLK)*DM+qcol;
  const bf16*Kh=K+rowbase*DM+qcol,*Vh=V+rowbase*DM+vcol;
  const unsigned lds0=(unsigned)(uintptr_t)shm;
  float*wsf=(float*)(shm+LDS_WS)+wid*64;
  const bf16*ksrc=Kh+(long)lane*DM+wid*8;
  const bf16*vsrc=Vh+(long)(16*(wid&3)+(lane>>2))*DM+(wid>>2)*32+(lane&3)*8;
  const unsigned kdst=lds0+LDS_K+wid*1024, vdst=lds0+LDS_V+wid*1024;
  #define DMA_K(t,slot) glds16(ksrc+(long)(t)*KVBLK*DM,(unsigned)__builtin_amdgcn_readfirstlane(kdst+(slot)))
  #define DMA_V(t,slot) glds16(vsrc+(long)(t)*KVBLK*DM,(unsigned)__builtin_amdgcn_readfirstlane(vdst+(slot)))
  const int vb0=(int)(lds0+LDS_V)+((lane>>4)&1)*32+(lane&3)*8+(4*hi+((lane&15)>>2))*64;
  const char*Kbase=shm+LDS_K; bf16x8 kf[8];
  const lds_cptr shm3=(lds_cptr)shm; const lds_cptr kp0=shm3+LDS_K+hi*1024+r32*16; const lds_cptr vp0=shm3+LDS_V+((lane>>4)&1)*32+(lane&3)*8+(4*hi+((lane&15)>>2))*64;
  const int NT=(q0+QB)/KVBLK;
  DMA_K(0,0);DMA_V(0,0);DMA_K(1,SLOTB);
  bf16x8 qr[4];
  #pragma unroll
  for(int d0=0;d0<4;++d0)qr[d0]=*reinterpret_cast<const bf16x8*>(&Qw[(long)r32*DM+d0*16+hi*8]);
  float mhat=0.f,l_reg=0.f;f32x16 o[2];o[0]=f32x16{};o[1]=f32x16{};f32x16 negm=f32x16{};asm volatile("":"+v"(negm));
  const int qrel=wid*QBLK+r32;
  #define CMASK(P0,P1,t) do{int jb_=(t)-(NT-4); if(jb_>=0)cmask(P0,P1,jb_,qrel,hi);}while(0)
  bool resc=false;
  #define START(P0,P1) do{ const float rm=rowmax(P0,P1); resc=false; \
    { const float dl=rm; mhat=fadd_s(mhat,dl); \
      _Pragma("unroll") for(int r=0;r<16;++r){P0[r]=fsub_s(P0[r],dl);P1[r]=fsub_s(P1[r],dl);} \
      _Pragma("unroll") for(int r=0;r<16;++r)negm[r]=-mhat; asm volatile("":"+v"(negm)); } \
    _Pragma("unroll") for(int r=0;r<16;++r)P0[r]=__builtin_amdgcn_exp2f(P0[r]); }while(0)
  #define RESC() do{ if(resc){ asm volatile("s_waitcnt lgkmcnt(0)":::"memory"); \
      _Pragma("unroll") for(int d_=0;d_<2;++d_) _Pragma("unroll") for(int r=0;r<16;++r)o[d_][r]*=wsf[crow(r,hi)]; } }while(0)
  f32x16 pA0,pA1,pB0,pB1;
  int sl_prev=0,sl_cur=0,sl_next=SLOTB;
  #define ROT() do{sl_prev=sl_cur;sl_cur=sl_next;sl_next=(sl_next==(NSLOT-1)*SLOTB)?0:sl_next+SLOTB;}while(0)
  DMA_K(2,2*SLOTB);
  WAIT_BAR(3);
  qkt(pA0,pA1,Kbase,qr,negm,r32,hi);asm volatile("s_nop 15\n\ts_nop 7":"+v"(pA0),"+v"(pA1));CMASK(pA0,pA1,0);
  START(pA0,pA1);
  _Pragma("unroll") for(int r=0;r<16;++r)pA1[r]=__builtin_amdgcn_exp2f(pA1[r]);
  WAIT_BAR(0);
  DMA_K(3,0);DMA_V(1,SLOTB);
  ROT();
  kload8(kf,kp0+sl_cur);
  WAIT_BAR(2);
  s16x4 vlo[8],vhi[8]; u32x4 pw0,pw1,pw2,pw3;
  #define PKW(P,B) cvtpk_s(P[B],P[B+1])
  #define PAF(k) __builtin_bit_cast(bf16x8,pw##k)
  #define VFR(i) (bf16x8){vlo[i][0],vlo[i][1],vlo[i][2],vlo[i][3],vhi[i][0],vhi[i][1],vhi[i][2],vhi[i][3]}
  #define PIN(x) asm volatile("":"+v"(x))
  #define MX3(a,b,c) __builtin_fmaxf(__builtin_fmaxf((a),(b)),(c))
  #define GAPA(MF,A0,A1,A2,A3,W0,W1,PW) do{ MF; sacc+=A0; sacc+=A1; sacc+=A2; sacc+=A3; PIN(sacc); W0; W1; PIN(PW); SBAR(); }while(0)
  #define EX(v) __builtin_amdgcn_exp2f(v)
  #define GAPB(MF,X,B) do{ MF; X[B]=EX(X[B]); X[B+1]=EX(X[B+1]); X[B+2]=EX(X[B+2]); X[B+3]=EX(X[B+3]); PIN(X); SBAR(); }while(0)
  #define VRD(i) do{ vlo[i]=vtr(vp_+(((i)>>2)*4096+((i)&3)*1024)); vhi[i]=vtr(vp_+(((i)>>2)*4096+((i)&3)*1024+512)); }while(0)
  #define KRD(G,j) do{ if(G){ kload2(kf,kp0+sl_next,j); SBAR(); } }while(0)
  #define STEP(C0,C1,P0,P1,t,GK,GV,GL) do{ SBAR(); \
    const lds_cptr vp_=vp0+sl_prev; \
    VRD(0); SBAR(); float sacc=(P0[0]+P0[1]); \
    GAPA(C0=__builtin_amdgcn_mfma_f32_32x32x16_bf16(kf[0],qr[0],negm,0,0,0), P0[2],P0[3],P0[4],P0[5],     pw0[0]=PKW(P0,0), pw0[1]=PKW(P0,2), pw0); \
    VRD(4); SBAR(); GAPA(C1=__builtin_amdgcn_mfma_f32_32x32x16_bf16(kf[1],qr[0],negm,0,0,0), P0[6],P0[7],P0[8],P0[9],     pw0[2]=PKW(P0,4), pw0[3]=PKW(P0,6), pw0); \
    VRD(1); SBAR(); GAPA(C0=__builtin_amdgcn_mfma_f32_32x32x16_bf16(kf[2],qr[1],C0,0,0,0),   P0[10],P0[11],P0[12],P0[13], pw1[0]=PKW(P0,8), pw1[1]=PKW(P0,10), pw1); \
    VRD(5); SBAR(); GAPA(C1=__builtin_amdgcn_mfma_f32_32x32x16_bf16(kf[3],qr[1],C1,0,0,0),   P0[14],P0[15],P1[0],P1[1],   pw1[2]=PKW(P0,12),pw1[3]=PKW(P0,14), pw1); \
    VRD(2); SBAR(); GAPA(C0=__builtin_amdgcn_mfma_f32_32x32x16_bf16(kf[4],qr[2],C0,0,0,0),   P1[2],P1[3],P1[4],P1[5],     pw2[0]=PKW(P1,0), pw2[1]=PKW(P1,2), pw2); \
    VRD(6); SBAR(); GAPA(C1=__builtin_amdgcn_mfma_f32_32x32x16_bf16(kf[5],qr[2],C1,0,0,0),   P1[6],P1[7],P1[8],P1[9],     pw2[2]=PKW(P1,4), pw2[3]=PKW(P1,6), pw2); \
    VRD(3); SBAR(); GAPA(C0=__builtin_amdgcn_mfma_f32_32x32x16_bf16(kf[6],qr[3],C0,0,0,0),   P1[10],P1[11],P1[12],P1[13], pw3[0]=PKW(P1,8), pw3[1]=PKW(P1,10), pw3); \
    VRD(7); SBAR(); GAPA(C1=__builtin_amdgcn_mfma_f32_32x32x16_bf16(kf[7],qr[3],C1,0,0,0),   P1[14],P1[15],0.f,0.f,       pw3[2]=PKW(P1,12),pw3[3]=PKW(P1,14), pw3); \
    l_reg+=sacc; \
    if(GK){DMA_K((t)+3,sl_cur);} if(GV){DMA_V((t)+1,sl_next);} \
    CMASK(C0,C1,t); \
    { float a=MX3(C0[0],C0[1],C1[0]),b=MX3(C0[2],C0[3],C1[1]); a=MX3(a,C1[2],C1[3]); \
      _Pragma("unroll") for(int r=4;r<16;r+=4){a=MX3(a,C0[r],C0[r+1]);b=MX3(b,C0[r+2],C0[r+3]);a=MX3(a,C1[r],C1[r+1]);b=MX3(b,C1[r+2],C1[r+3]);} \
      float rm=__builtin_fmaxf(a,b); { auto rr=__builtin_amdgcn_permlane32_swap(__float_as_uint(rm),__float_as_uint(rm),false,false); rm=__builtin_fmaxf(__uint_as_float(rr[0]),__uint_as_float(rr[1])); } \
      resc=false; \
      if(__builtin_expect(__any(rm>(float)THRL),0)){ const float dl=__builtin_fmaxf(rm,0.f); mhat+=dl; \
        _Pragma("unroll") for(int r=0;r<16;++r){C0[r]-=dl;C1[r]-=dl;} \
        _Pragma("unroll") for(int r=0;r<16;++r)negm[r]=-mhat; asm volatile("":"+v"(negm)); \
        const float f=__builtin_amdgcn_exp2f(-dl); l_reg*=f; if(hi==0)wsf[r32]=f; resc=true; } } \
    SBAR(); \
    GAPB(o[0]=__builtin_amdgcn_mfma_f32_32x32x16_bf16(PAF(0),VFR(0),o[0],0,0,0), C0,0); \
    GAPB(o[1]=__builtin_amdgcn_mfma_f32_32x32x16_bf16(PAF(0),VFR(4),o[1],0,0,0), C0,4); \
    KRD(GL,0); GAPB(o[0]=__builtin_amdgcn_mfma_f32_32x32x16_bf16(PAF(1),VFR(1),o[0],0,0,0), C0,8); \
    KRD(GL,1); GAPB(o[1]=__builtin_amdgcn_mfma_f32_32x32x16_bf16(PAF(1),VFR(5),o[1],0,0,0), C0,12); \
    KRD(GL,2); GAPB(o[0]=__builtin_amdgcn_mfma_f32_32x32x16_bf16(PAF(2),VFR(2),o[0],0,0,0), C1,0); \
    KRD(GL,3); GAPB(o[1]=__builtin_amdgcn_mfma_f32_32x32x16_bf16(PAF(2),VFR(6),o[1],0,0,0), C1,4); \
    GAPB(o[0]=__builtin_amdgcn_mfma_f32_32x32x16_bf16(PAF(3),VFR(3),o[0],0,0,0), C1,8); \
    GAPB(o[1]=__builtin_amdgcn_mfma_f32_32x32x16_bf16(PAF(3),VFR(7),o[1],0,0,0), C1,12); \
    }while(0)
  int t=1;
  #undef CMASK
  #define CMASK(P0,P1,t) do{}while(0)
  for(;t+5<NT;t+=2){
    STEP(pB0,pB1,pA0,pA1,t,true,true,true);     WAIT_BAR(2); RESC(); ROT();
    STEP(pA0,pA1,pB0,pB1,t+1,true,true,true);   WAIT_BAR(2); RESC(); ROT();
  }
  #undef CMASK
  #define CMASK(P0,P1,t) do{int jb_=(t)-(NT-4); if(jb_>=0)cmask(P0,P1,jb_,qrel,hi);}while(0)
  #define ENDW(tt) do{ if((tt)+3<NT){WAIT_BAR(2);} else if((tt)+2<NT){WAIT_BAR(1);} else {WAIT_BAR(0);} }while(0)
  for(;t+1<NT;t+=2){
    STEP(pB0,pB1,pA0,pA1,t,(t+3<NT),(t+1<NT),(t+1<NT));       ENDW(t);   RESC(); ROT();
    STEP(pA0,pA1,pB0,pB1,t+1,(t+4<NT),(t+2<NT),(t+2<NT));     ENDW(t+1); RESC(); ROT();
  }
  STEP(pB0,pB1,pA0,pA1,NT-1,false,false,false); RESC();
  { float sacc=pB0[0]+pB0[1]; _Pragma("unroll") for(int r=2;r<16;++r)sacc+=pB0[r]; _Pragma("unroll") for(int r=0;r<16;++r)sacc+=pB1[r]; l_reg+=sacc;
    pw0=(u32x4){PKW(pB0,0),PKW(pB0,2),PKW(pB0,4),PKW(pB0,6)};pw1=(u32x4){PKW(pB0,8),PKW(pB0,10),PKW(pB0,12),PKW(pB0,14)};pw2=(u32x4){PKW(pB1,0),PKW(pB1,2),PKW(pB1,4),PKW(pB1,6)};pw3=(u32x4){PKW(pB1,8),PKW(pB1,10),PKW(pB1,12),PKW(pB1,14)};
    SBAR(); pv(o,vb0+sl_cur,PAF(0),PAF(1),PAF(2),PAF(3)); }
  #undef PKW
  #undef PAF
  #undef VFR
  #undef PIN
  #undef MX3
  #undef GAPA
  #undef GAPB
  #undef EX
  #undef VRD
  #undef KRD
  #undef STEP
  #undef ENDW
  {auto rr=__builtin_amdgcn_permlane32_swap(__float_as_uint(l_reg),__float_as_uint(l_reg),false,false);l_reg=__uint_as_float(rr[0])+__uint_as_float(rr[1]);}
  if(hi==0)wsf[32+r32]=l_reg;asm volatile("s_waitcnt lgkmcnt(0)":::"memory");
  float rli[16];
  #pragma unroll
  for(int r=0;r<16;++r)rli[r]=__builtin_amdgcn_rcpf(wsf[32+crow(r,hi)]);
  bf16*Ow=O+(rowbase+q0+wid*QBLK)*DM+vcol;
  { bf16*stg=(bf16*)(shm+LDS_OST)+wid*2048;
    #pragma unroll
    for(int r=0;r<16;++r){const int orow=crow(r,hi);
      #pragma unroll
      for(int d0=0;d0<2;++d0)stg[orow*64+d0*32+r32]=__float2bfloat16(o[d0][r]*rli[r]);}
    asm volatile("s_waitcnt lgkmcnt(0)":::"memory");
    #pragma unroll
    for(int i=0;i<4;++i){const int row=i*8+(lane>>3),ch=lane&7; const u32x4 v=*(const u32x4*)(stg+row*64+ch*8); ATTN_STORE16(Ow+(long)row*DM+ch*8,v);} }
  asm volatile("s_waitcnt lgkmcnt(0)\n\ts_barrier":::"memory");
  #undef DMA_K
  #undef DMA_V
  #undef CMASK
  #undef START
  #undef RESC
  #undef ROT
}
constexpr int ATTN_LDS_BYTES=LDS_BYTES;
struct AttnTensors { const bf16* Q; const bf16* K; const bf16* V; bf16* O1; bf16* O2; };
struct AttnUnit { int bh; int qb; };
struct StaticOrder {
  int vcu, G;
  __device__ __forceinline__ explicit StaticOrder(int grid,int vcu_):vcu(vcu_),G(grid){}
  __device__ __forceinline__ bool next(int i,AttnUnit&u)const{
    if(G==256){ if(i>=4)return false; const int s=vcu&3; u.bh=vcu>>2; u.qb=(i==0)?s:(i==1)?7-s:(i==2)?8+s:15-s; return true; }
    const int L=vcu+i*G; if(L>=1024)return false; u.bh=L>>4; u.qb=15-(L&15); return true; }
  __device__ __forceinline__ void a_ready(const AttnUnit&)const{}
  __device__ __forceinline__ void done(const AttnUnit&)const{}
};
template<class Sched,int THRL=8> __device__ __forceinline__ void attn_phase(char*lds,const AttnTensors&T,const Sched&S){
  AttnUnit u;
  for(int i=0;S.next(i,u);++i){ S.a_ready(u); const int b=u.bh>>5,rem=u.bh&31,h=rem>>2,map=(rem>>1)&1,vh=rem&1;
    attn_unit<THRL>(b,h*128+map*64,h*128+vh*64,u.qb,T.Q,T.K,T.V,map?T.O2:T.O1,lds); S.done(u); }
}
#undef SBAR
#undef WAIT_BAR
}
namespace dsa_body {
typedef short bf16x8 __attribute__((ext_vector_type(8)));
typedef short s16x4 __attribute__((ext_vector_type(4)));
typedef float f32x4 __attribute__((ext_vector_type(4)));
typedef float f32x16 __attribute__((ext_vector_type(16)));
typedef unsigned u32x4 __attribute__((ext_vector_type(4)));
typedef unsigned short bf16;
#define DL __attribute__((address_space(3)))
#define DG __attribute__((address_space(1)))
constexpr int SEQ = 4096;
constexpr int L_KBUF = 0, L_HIST = 65536, L_SEL = L_HIST + 16 * 4096, L_TOTAL = L_SEL + 8 * 1280;
constexpr int CAND_CAP = 1024;

__device__ __forceinline__ unsigned ordkey(float x) { const unsigned u = __float_as_uint(x); return u ^ ((unsigned)((int)u >> 31) | 0x80000000u); }
__device__ __forceinline__ float relu1(float x) { const int i = __builtin_bit_cast(int, x); return __builtin_bit_cast(float, i > 0 ? i : 0); }
__device__ __forceinline__ unsigned mbcnt64(unsigned long long m) { return __builtin_amdgcn_mbcnt_hi((unsigned)(m >> 32), __builtin_amdgcn_mbcnt_lo((unsigned)m, 0u)); }
__device__ __forceinline__ void wg_barrier() { asm volatile("s_waitcnt vmcnt(0) lgkmcnt(0)\n\ts_barrier" ::: "memory"); }

__device__ __forceinline__ void idx_scores(DL unsigned char* lds, const bf16* Qi, const bf16* Ki, const float* Wi, float* SC, int b, int q0, int tid, int wave, int lane) {
    const int hi = lane >> 5, r32 = lane & 31, t0 = q0 + 2 * wave;
    const size_t rowb = (size_t)b * SEQ;
    bf16x8 af[4]; float wv[16];
    {   const int aq = (r32 >> 2) & 1, ah = (r32 & 3) + 4 * (r32 >> 3);
        const bf16* ap = Qi + (rowb + t0 + aq) * 1024 + ah * 64 + hi * 8;
#pragma unroll
        for (int kk = 0; kk < 4; ++kk) af[kk] = *(const DG bf16x8*)(ap + kk * 16);
        const float* wp = Wi + (rowb + t0 + hi) * 16;
#pragma unroll
        for (int i = 0; i < 4; ++i) { const f32x4 w4 = *(const DG f32x4*)(wp + 4 * i); wv[4 * i] = w4[0]; wv[4 * i + 1] = w4[1]; wv[4 * i + 2] = w4[2]; wv[4 * i + 3] = w4[3]; } }
    const int nch = (q0 + 16 + 255) >> 8;
    u32x4 st[4];
    const int srow = tid >> 3, sc16 = tid & 7;
    const bf16* kg = Ki + (rowb + srow) * 64 + sc16 * 8;
#pragma unroll
    for (int p = 0; p < 4; ++p) st[p] = *(const DG u32x4*)(kg + (size_t)(64 * p) * 64);
#pragma unroll
    for (int p = 0; p < 4; ++p) { const int row = 64 * p + srow; *(DL u32x4*)(lds + L_KBUF + row * 128 + 16 * (sc16 ^ ((row >> 1) & 7))) = st[p]; }
    wg_barrier();
    float* srowp = SC + (rowb + t0 + hi) * (size_t)SEQ + r32;
    DL unsigned* hq = (DL unsigned*)(lds + L_HIST + (2 * wave + hi) * 4096);
    const int tq = t0 + hi;
    for (int c = 0; c < nch; ++c) {
        const bool more = (c + 1 < nch);
        if (more) {
#pragma unroll
            for (int p = 0; p < 4; ++p) st[p] = *(const DG u32x4*)(kg + (size_t)(256 * (c + 1) + 64 * p) * 64); }
        const DL unsigned char* buf = lds + L_KBUF + (c & 1) * 32768;
        const int kbase = 256 * c;
#define IDX_LOADB(TT, BUF) do { const int row_ = 32 * (TT) + r32; const DL unsigned char* rp_ = buf + row_ * 128; const int sw_ = (row_ >> 1) & 7; \
            _Pragma("unroll") for (int kk = 0; kk < 4; ++kk) bq[BUF][kk] = *(const DL bf16x8*)(rp_ + 16 * ((2 * kk + hi) ^ sw_)); } while (0)
#define IDX_EPI(TT, ACC) do { float s0_ = 0.f, s1_ = 0.f; \
            _Pragma("unroll") for (int r = 0; r < 16; r += 2) { s0_ += wv[r] * relu1(ACC[r]); s1_ += wv[r + 1] * relu1(ACC[r + 1]); } \
            const float s_ = s0_ + s1_; \
            *(DG float*)(srowp + kbase + 32 * (TT)) = s_; \
            const unsigned bin_ = ordkey(s_) >> 21; const unsigned inc_ = (kbase + 32 * (TT) + r32 <= tq) ? ((bin_ & 1u) ? 65536u : 1u) : 0u; \
            __hip_atomic_fetch_add(hq + (bin_ >> 1), inc_, __ATOMIC_RELAXED, __HIP_MEMORY_SCOPE_WORKGROUP); } while (0)
        {   bf16x8 bq[2][4]; f32x16 accA, accB;
            IDX_LOADB(0, 0);
#pragma unroll
            for (int T = 0; T < 8; ++T) {
                if (T + 1 < 8) { if ((T & 1) == 0) IDX_LOADB(T + 1, 1); else IDX_LOADB(T + 1, 0); }
                __builtin_amdgcn_sched_barrier(0);
                f32x16 acc = {0.f, 0.f, 0.f, 0.f, 0.f, 0.f, 0.f, 0.f, 0.f, 0.f, 0.f, 0.f, 0.f, 0.f, 0.f, 0.f};
#pragma unroll
                for (int kk = 0; kk < 4; ++kk) acc = __builtin_amdgcn_mfma_f32_32x32x16_bf16(af[kk], bq[T & 1][kk], acc, 0, 0, 0);
                if ((T & 1) == 0) { if (T > 0) IDX_EPI(T - 1, accB); accA = acc; } else { IDX_EPI(T - 1, accA); accB = acc; }
                __builtin_amdgcn_sched_barrier(0);
            }
            IDX_EPI(7, accB);
        }
#undef IDX_LOADB
#undef IDX_EPI
        if (more) {
#pragma unroll
            for (int p = 0; p < 4; ++p) { const int row = 64 * p + srow; *(DL u32x4*)(lds + L_KBUF + ((c + 1) & 1) * 32768 + row * 128 + 16 * (sc16 ^ ((row >> 1) & 7))) = st[p]; } }
        wg_barrier();
    }
}

__device__ __forceinline__ void hist_scan(const DL unsigned* hist, unsigned need, int lane, int& tb, unsigned& above) {
    u32x4 w[4];
#pragma unroll
    for (int i = 0; i < 4; ++i) w[i] = *(const DL u32x4*)(hist + 16 * lane + 4 * i);
    unsigned tot = 0u;
#pragma unroll
    for (int i = 0; i < 4; ++i)
#pragma unroll
        for (int e = 0; e < 4; ++e) tot += (w[i][e] & 0xffffu) + (w[i][e] >> 16);
    unsigned incl = tot;
#pragma unroll
    for (int o = 1; o < 64; o <<= 1) { const unsigned tv = __shfl_down(incl, o); if (lane + o < 64) incl += tv; }
    const unsigned excl = incl - tot;
    const unsigned long long hm = __ballot((excl < need) && (need <= incl));
    const int Ls = hm ? (int)__builtin_ctzll(hm) : 0;
    const unsigned exL = (unsigned)__shfl((int)excl, Ls);
    const unsigned cj = lane < 32 ? (unsigned)((const DL unsigned short*)hist)[32 * Ls + lane] : 0u;
    unsigned sfx = cj;
#pragma unroll
    for (int o = 1; o < 64; o <<= 1) { const unsigned tv = __shfl_down(sfx, o); if (lane + o < 64) sfx += tv; }
    const unsigned long long cm = __ballot(lane < 32 && exL + sfx >= need);
    const int tbl = cm ? 63 - (int)__builtin_clzll(cm) : 0;
    tb = 32 * Ls + tbl; above = exL + (unsigned)__shfl((int)(sfx - cj), tbl);
}
__device__ __forceinline__ void hist_zero(DL unsigned* hist, int lane) {
#pragma unroll
    for (int i = 0; i < 4; ++i) *(DL u32x4*)(hist + 4 * lane + 256 * i) = (u32x4){0u, 0u, 0u, 0u};
    asm volatile("s_waitcnt lgkmcnt(0)" ::: "memory");
}
__device__ __forceinline__ void select_stream(const float* srow, int n, DL unsigned* hist, DL unsigned* sel, int lane, unsigned prefix, int need) {
    const int nq = (n + 255) >> 8;
#pragma unroll
    for (int pass = 1; pass < 3; ++pass) {
        const int sh = pass == 1 ? 10 : 0; const unsigned bmask = pass == 2 ? 1023u : 2047u;
        hist_zero(hist, lane);
        for (int i = 0; i < nq; ++i) {
            const int j = 256 * i + 4 * lane;
            const f32x4 x = *(const DG f32x4*)(srow + j);
#pragma unroll
            for (int e = 0; e < 4; ++e) {
                const unsigned key = ordkey(x[e]);
                const bool ok = (j + e < n) && (pass == 1 ? ((key >> 21) == (prefix >> 21)) : ((key >> 10) == (prefix >> 10)));
                const unsigned bin = (key >> sh) & bmask;
                __hip_atomic_fetch_add(hist + (bin >> 1), ok ? ((bin & 1u) ? 65536u : 1u) : 0u, __ATOMIC_RELAXED, __HIP_MEMORY_SCOPE_WORKGROUP);
            }
        }
        asm volatile("s_waitcnt lgkmcnt(0)" ::: "memory");
        int tb; unsigned above; hist_scan(hist, (unsigned)need, lane, tb, above);
        prefix |= ((unsigned)tb << sh); need -= (int)above;
    }
    const unsigned T = prefix; const int need3 = need, above_total = 256 - need3;
    int base_gt = 0, base_eq = 0;
    const int ni = (n + 63) >> 6;
    for (int i = 0; i < ni; ++i) {
        const int j = 64 * i + lane; const bool valid = j < n;
        const float x = valid ? *(const DG float*)(srow + j) : 0.f; const unsigned key = ordkey(x);
        const bool gt = valid && key > T, eq = valid && key == T;
        const unsigned long long bg = __ballot(gt), be = __ballot(eq);
        const int pg = (int)mbcnt64(bg), pe = (int)mbcnt64(be);
        if (gt) sel[base_gt + pg] = (unsigned)j;
        if (eq && base_eq + pe < need3) sel[above_total + base_eq + pe] = (unsigned)j;
        base_gt += __builtin_popcountll(bg); base_eq += __builtin_popcountll(be);
    }
    asm volatile("s_waitcnt lgkmcnt(0)" ::: "memory");
}
__device__ __forceinline__ void topk256(const float* srow, int n, DL unsigned* hist, DL unsigned* sel, DL unsigned* cand  , int lane) {
    int tb; unsigned above; hist_scan(hist, 256u, lane, tb, above);
    int need = 256 - (int)above;
    const int nq = (n + 255) >> 8;
    int base_gt = 0, base_c = 0;
    f32x4 xn = *(const DG f32x4*)(srow + 4 * lane);
    for (int i = 0; i < nq; ++i) {
        const f32x4 x = xn; const int j = 256 * i + 4 * lane;
        if (i + 1 < nq) xn = *(const DG f32x4*)(srow + j + 256);
#pragma unroll
        for (int e = 0; e < 4; ++e) {
            const unsigned key = ordkey(x[e]); const int bin = (int)(key >> 21); const bool valid = (j + e < n);
            const bool gt = valid && bin > tb, eq = valid && bin == tb;
            const unsigned long long bg = __ballot(gt), be = __ballot(eq);
            const int pg = base_gt + (int)mbcnt64(bg), pc = base_c + (int)mbcnt64(be);
            if (gt) sel[pg] = (unsigned)(j + e);
            if (eq && pc < CAND_CAP) { cand[pc] = key; cand[CAND_CAP + pc] = (unsigned)(j + e); }
            base_gt += __builtin_popcountll(bg); base_c += __builtin_popcountll(be);
        }
    }
    asm volatile("s_waitcnt lgkmcnt(0)" ::: "memory");
    if (base_c > CAND_CAP) { select_stream(srow, n, hist, sel, lane, (unsigned)tb << 21, need); return; }
    const int C = base_c, nk = (C + 63) >> 6;
    unsigned prefix = (unsigned)tb << 21;
#pragma unroll
    for (int pass = 1; pass < 3; ++pass) {
        const int sh = pass == 1 ? 10 : 0; const unsigned bmask = pass == 2 ? 1023u : 2047u;
        hist_zero(hist, lane);
        for (int k = 0; k < nk; ++k) { const int c = 64 * k + lane;
            if (c < C) { const unsigned key = cand[c]; const bool ok = pass == 1 ? true : ((key >> 10) == (prefix >> 10)); const unsigned bin = (key >> sh) & bmask;
                __hip_atomic_fetch_add(hist + (bin >> 1), ok ? ((bin & 1u) ? 65536u : 1u) : 0u, __ATOMIC_RELAXED, __HIP_MEMORY_SCOPE_WORKGROUP); } }
        asm volatile("s_waitcnt lgkmcnt(0)" ::: "memory");
        int tb2; unsigned ab2; hist_scan(hist, (unsigned)need, lane, tb2, ab2);
        prefix |= ((unsigned)tb2 << sh); need -= (int)ab2;
    }
    const unsigned T = prefix; const int need3 = need;
    for (int k = 0; k < nk; ++k) { const int c = 64 * k + lane; const bool gt = (c < C) && cand[c] > T;
        const unsigned long long bg = __ballot(gt);
        if (gt) sel[base_gt + (int)mbcnt64(bg)] = cand[CAND_CAP + c];
        base_gt += __builtin_popcountll(bg); }
    int last = -1;
    for (int r = 0; r < need3; ++r) {
        int best = 0x7fffffff;
        for (int k = 0; k < nk; ++k) { const int c = 64 * k + lane; if (c < C && cand[c] == T) { const int idx = (int)cand[CAND_CAP + c]; if (idx > last && idx < best) best = idx; } }
#pragma unroll
        for (int o = 1; o < 64; o <<= 1) { const int ov = __shfl_xor(best, o); best = ov < best ? ov : best; }
        if (lane == 0) sel[base_gt + r] = (unsigned)best;
        last = best;
    }
    asm volatile("s_waitcnt lgkmcnt(0)" ::: "memory");
}

__device__ __forceinline__ s16x4 vtr(DL const unsigned char* p) { typedef short v4i16_t __attribute__((ext_vector_type(4))); return __builtin_bit_cast(s16x4, __builtin_amdgcn_ds_read_tr16_b64_v4i16((DL v4i16_t*)p)); }
__device__ __forceinline__ unsigned cvtpk(float lo, float hi) { typedef float f2 __attribute__((ext_vector_type(2))); typedef __bf16 b2 __attribute__((ext_vector_type(2))); f2 v = {lo, hi}; b2 r = __builtin_convertvector(v, b2); return __builtin_bit_cast(unsigned, r); }
__device__ __forceinline__ unsigned offb(unsigned row, unsigned ch) { return 256u * row + 16u * (ch ^ (((row & 3u) << 2) | ((row >> 2) & 3u))); }
__device__ __forceinline__ void sparse_attn(DL unsigned char* vst, const DL unsigned* sel, int nsel, const bf16* Qs, const unsigned char* Ks8, const unsigned char* Vs8, bf16* MIX, int b, int t, int lane) {
    typedef float f2 __attribute__((ext_vector_type(2)));
    const int c16 = lane & 15, g = lane >> 4; const size_t rowb = (size_t)b * SEQ;
    long qf[4];
    {   const bf16* qp = Qs + (rowb + t) * 1024 + (c16 & 7) * 128 + g * 32;
#pragma unroll
        for (int kk = 0; kk < 4; ++kk) { const u32x4 w = *(const DG u32x4*)(qp + kk * 8);
            float f[8];
#pragma unroll
            for (int i = 0; i < 4; ++i) { f[2 * i] = __uint_as_float(w[i] << 16) * 8.0f; f[2 * i + 1] = __uint_as_float(w[i] & 0xffff0000u) * 8.0f; }
            int lo = __builtin_amdgcn_cvt_pk_fp8_f32(f[0], f[1], 0, false); lo = __builtin_amdgcn_cvt_pk_fp8_f32(f[2], f[3], lo, true);
            int hi = __builtin_amdgcn_cvt_pk_fp8_f32(f[4], f[5], 0, false); hi = __builtin_amdgcn_cvt_pk_fp8_f32(f[6], f[7], hi, true);
            qf[kk] = (long)(((unsigned long long)(unsigned)hi << 32) | (unsigned long long)(unsigned)lo); } }
    const int nblk = (nsel + 31) >> 5;
    f32x4 o[8];
#pragma unroll
    for (int c = 0; c < 8; ++c) o[c] = (f32x4){0.f, 0.f, 0.f, 0.f};
    float mrun = -INFINITY, l = 0.f;
    const unsigned q4 = (unsigned)(c16 >> 2), p4 = (unsigned)(lane & 3);
    const DG unsigned char* Kb = (const DG unsigned char*)(Ks8 + rowb * 128); const DG unsigned char* Vb = (const DG unsigned char*)(Vs8 + rowb * 128);
    const unsigned koff = (unsigned)g * 32u, voff = (unsigned)(lane & 7) * 16u;
    u32x4 kw[2][2], vv[4];
#define DSA_LOADK(TB) do { _Pragma("unroll") for (int tt = 0; tt < 2; ++tt) { const unsigned idx = sel[32 * (TB) + 16 * tt + c16]; \
        kw[tt][0] = *(const DG u32x4*)(Kb + (idx * 128u + koff)); kw[tt][1] = *(const DG u32x4*)(Kb + (idx * 128u + koff + 16u)); } } while (0)
#define DSA_LOADV(TB) do { _Pragma("unroll") for (int pp = 0; pp < 4; ++pp) { const unsigned idx = sel[32 * (TB) + 8 * pp + (lane >> 3)]; \
        vv[pp] = *(const DG u32x4*)(Vb + (idx * 128u + voff)); } } while (0)
    DSA_LOADK(0); DSA_LOADV(0);
    for (int Tb = 0; Tb < nblk; ++Tb) {
        f32x4 sv[2];
#pragma unroll
        for (int tt = 0; tt < 2; ++tt) {
            f32x4 acc = {0.f, 0.f, 0.f, 0.f};
#pragma unroll
            for (int kk = 0; kk < 4; ++kk) { const u32x4 w = kw[tt][kk >> 1]; const unsigned lo = (kk & 1) ? w.z : w.x, hi = (kk & 1) ? w.w : w.y;
                acc = __builtin_amdgcn_mfma_f32_16x16x32_fp8_fp8((long)(((unsigned long long)hi << 32) | (unsigned long long)lo), qf[kk], acc, 0, 0, 0); }
            acc = acc * 0.125f;
            if (32 * Tb + 32 > nsel) {
#pragma unroll
                for (int r = 0; r < 4; ++r) if (32 * Tb + 16 * tt + 4 * g + r >= nsel) acc[r] = -INFINITY; }
            sv[tt] = acc;
        }
        if (Tb + 1 < nblk) DSA_LOADK(Tb + 1);
        float bm = fmaxf(fmaxf(fmaxf(sv[0][0], sv[0][1]), fmaxf(sv[0][2], sv[0][3])), fmaxf(fmaxf(sv[1][0], sv[1][1]), fmaxf(sv[1][2], sv[1][3])));
        bm = fmaxf(bm, __shfl_xor(bm, 16)); bm = fmaxf(bm, __shfl_xor(bm, 32));
        const float mnew = fmaxf(mrun, bm), alpha = __builtin_amdgcn_exp2f(mrun - mnew); mrun = mnew;
        float ps = 0.f;
#pragma unroll
        for (int tt = 0; tt < 2; ++tt)
#pragma unroll
            for (int r = 0; r < 4; ++r) { const float p = __builtin_amdgcn_exp2f(sv[tt][r] - mnew); sv[tt][r] = p; ps += p; }
        l = l * alpha + ps;
#pragma unroll
        for (int c = 0; c < 8; ++c) o[c] = o[c] * alpha;
        asm volatile("s_waitcnt lgkmcnt(0)" ::: "memory");
#pragma unroll
        for (int pp = 0; pp < 4; ++pp) {
            const int jj = 8 * pp + (lane >> 3); const unsigned rho = 8u * ((jj & 15) >> 2) + 4u * (jj >> 4) + (jj & 3), ch0 = 2u * (lane & 7);
            u32x4 wlo, whi;
#pragma unroll
            for (int d = 0; d < 4; ++d) { const f2 a = __builtin_amdgcn_cvt_pk_f32_fp8((int)vv[pp][d], false), c2 = __builtin_amdgcn_cvt_pk_f32_fp8((int)vv[pp][d], true);
                const unsigned w0 = cvtpk(a[0], a[1]), w1 = cvtpk(c2[0], c2[1]);
                if (d < 2) { wlo[2 * d] = w0; wlo[2 * d + 1] = w1; } else { whi[2 * (d - 2)] = w0; whi[2 * (d - 2) + 1] = w1; } }
            *(DL u32x4*)(vst + offb(rho, ch0)) = wlo; *(DL u32x4*)(vst + offb(rho, ch0 + 1u)) = whi; }
        if (Tb + 1 < nblk) DSA_LOADV(Tb + 1);
        asm volatile("s_waitcnt lgkmcnt(0)" ::: "memory");
        u32x4 pw; pw.x = cvtpk(sv[0][0], sv[0][1]); pw.y = cvtpk(sv[0][2], sv[0][3]); pw.z = cvtpk(sv[1][0], sv[1][1]); pw.w = cvtpk(sv[1][2], sv[1][3]);
        const bf16x8 pa = __builtin_bit_cast(bf16x8, pw);
#pragma unroll
        for (int c = 0; c < 8; ++c) {
            const unsigned ch = 2u * c + (p4 >> 1);
            const s16x4 lo = vtr(vst + offb(8u * g + q4, ch) + 8u * (p4 & 1)), hi4 = vtr(vst + offb(8u * g + 4u + q4, ch) + 8u * (p4 & 1));
            const bf16x8 vfr = (bf16x8){lo[0], lo[1], lo[2], lo[3], hi4[0], hi4[1], hi4[2], hi4[3]};
            o[c] = __builtin_amdgcn_mfma_f32_16x16x32_bf16(vfr, pa, o[c], 0, 0, 0);
        }
    }
#undef DSA_LOADK
#undef DSA_LOADV
    l += __shfl_xor(l, 16); l += __shfl_xor(l, 32);
    const float linv = 1.0f / l;
    if (c16 < 8) {
        bf16* op = MIX + (rowb + t) * 2048 + 1024 + c16 * 128 + 4 * g;
#pragma unroll
        for (int c = 0; c < 8; ++c) { typedef unsigned u32x2 __attribute__((ext_vector_type(2))); u32x2 w2; w2.x = cvtpk(o[c][0] * linv, o[c][1] * linv); w2.y = cvtpk(o[c][2] * linv, o[c][3] * linv); *(DG u32x2*)(op + 16 * c) = w2; }
    }
}

struct DsaTensors { const bf16* Qi; const bf16* Ki; const float* Wi; const bf16* Qs; const bf16* Ks; const bf16* Vs; bf16* MIX; float* SC; const unsigned char* Ks8; const unsigned char* Vs8; };
template <class Hook>
__device__ __forceinline__ void dsa_unit(DL unsigned char* lds, const DsaTensors& T, int b, int q0, int tid, int wave, int lane, const Hook& hook, int slot0) {
    wg_barrier();
#pragma unroll
    for (int i = 0; i < 8; ++i) *(DL u32x4*)(lds + L_HIST + (i * 512 + tid) * 16) = (u32x4){0u, 0u, 0u, 0u};
#ifndef NO_IDX
    idx_scores(lds, T.Qi, T.Ki, T.Wi, T.SC, b, q0, tid, wave, lane);
#endif
    asm volatile("s_waitcnt vmcnt(0)" ::: "memory");
    DL unsigned* sel = (DL unsigned*)(lds + L_SEL + wave * 1280); DL unsigned char* vst = lds + L_KBUF + wave * 8192;
#pragma unroll 1
    for (int qi = 0; qi < 2; ++qi) {
        const int t = q0 + 2 * wave + qi, n = t + 1;
        int nsel;
        if (n <= 256) { for (int j = lane; j < 256; j += 64) sel[j] = j < n ? (unsigned)j : 0u; asm volatile("s_waitcnt lgkmcnt(0)" ::: "memory"); nsel = n; }
        else {
#ifndef NO_TOPK
            topk256(T.SC + ((size_t)b * SEQ + t) * SEQ, n, (DL unsigned*)(lds + L_HIST + (2 * wave + qi) * 4096), sel, (DL unsigned*)vst, lane);
#endif
            nsel = 256; }
#ifndef NO_SPARSE
        { int l2 = lane; asm volatile("" : "+v"(l2) :: "memory"); __builtin_amdgcn_sched_barrier(0);
          sparse_attn(vst, sel, nsel, T.Qs, T.Ks8, T.Vs8, T.MIX, b, t, l2);
          asm volatile("s_waitcnt lgkmcnt(0)" ::: "memory"); hook(slot0 + qi, vst, l2); }
#endif
    }
}
template <class Hook>
__device__ __forceinline__ void dsa_phase(DL unsigned char* lds, const DsaTensors& T, int vcu, int G, int tid, int wave, int lane, const Hook& hook) {
    if (G == 256) {
#pragma unroll 1
        for (int it = 0; it < 2; ++it) { const int L = it ? 511 - vcu : vcu; dsa_unit(lds, T, L >> 8, 16 * (L & 255), tid, wave, lane, hook, 2 * it); }
    } else {
#pragma unroll 1
        for (int L = vcu; L < 512; L += G) dsa_unit(lds, T, L >> 8, 16 * (L & 255), tid, wave, lane, hook, 4);
    }
}
#undef DL
#undef DG
}
constexpr int NWAVES = 8;
constexpr int RING_OFF = 0, RING_BYTES = 143360;
constexpr int LDSCTL_OFF = RING_BYTES, MISC_OFF = LDSCTL_OFF + 320;
constexpr int LDS_BYTES = 147456;
static_assert(MISC_OFF + 128 <= LDS_BYTES, "LDS map");

struct Args { const void* in[19]; float* out; unsigned char* ws; int ph_lo, ph_hi; };
static_assert(sizeof(Args) == 19 * 8 + 8 + 8 + 8, "Args has no padding");

struct Frame {
    LAS unsigned char* lds;
    volatile LAS unsigned* MISC;
    gu32* ctl;
    int tid, lane, wave;
    int vcu, G;
};

__device__ __forceinline__ float wave_sum(float v) {
#pragma unroll
    for (int o = 1; o < 64; o <<= 1) v += __shfl_xor(v, o);
    return v;
}
template <class RowMap>
__device__ __forceinline__ void p0_transpose_item(const float* W, int K, int ldw, int nvalid, bf16* WT, LAS float* scr, int kb, int nb, int lane, RowMap rm) {
    const int k0 = 64 * kb, n0 = 32 * nb;
    const int n4 = 4 * (lane & 7), kr = lane >> 3;
    f32x4 v[8];
    if (n0 + 32 <= nvalid && (ldw & 3) == 0) {
#pragma unroll
        for (int i = 0; i < 8; ++i) v[i] = *(const GAS f32x4*)(W + (size_t)(k0 + kr + 8 * i) * ldw + n0 + n4);
    } else {
#pragma unroll
        for (int i = 0; i < 8; ++i) { const float* p = W + (size_t)(k0 + kr + 8 * i) * ldw + n0 + n4;
            v[i].x = (n0 + n4 + 0 < nvalid) ? p[0] : 0.f; v[i].y = (n0 + n4 + 1 < nvalid) ? p[1] : 0.f; v[i].z = (n0 + n4 + 2 < nvalid) ? p[2] : 0.f; v[i].w = (n0 + n4 + 3 < nvalid) ? p[3] : 0.f; }
    }
#pragma unroll
    for (int i = 0; i < 8; ++i) *(LAS f32x4*)(scr + (kr + 8 * i) * 32 + (n4 ^ (4 * i))) = v[i];
    LDS_WAIT(); asm volatile("" ::: "memory");
    const int c = lane & 7;
#pragma unroll
    for (int j = 0; j < 4; ++j) { const int n = (lane >> 3) + 8 * j; const LAS float* s = scr + (8 * c) * 32 + (n ^ (4 * c));
        v4u o; o.x = pk2(s[0 * 32], s[1 * 32]); o.y = pk2(s[2 * 32], s[3 * 32]); o.z = pk2(s[4 * 32], s[5 * 32]); o.w = pk2(s[6 * 32], s[7 * 32]);
        *(GAS v4u*)(WT + (size_t)rm(n0 + n) * K + k0 + 8 * c) = o; }
    LDS_WAIT(); asm volatile("" ::: "memory");
}
struct RmId { __device__ __forceinline__ int operator()(int n) const { return n; } };
struct RmGate { int add; __device__ __forceinline__ int operator()(int n) const { return 256 * (n >> 7) + (n & 127) + add; } };

constexpr int I_FG = 32 * (FF / 32), I_FD = (FF / 64) * (DM / 32), N_FFN_ITEMS = 2 * I_FG + I_FD;
constexpr int P2_IDLE_FIRST = 192, P2_IDLE_PER_WAVE = 13, N_FFN_P2 = (256 - P2_IDLE_FIRST) * 8 * P2_IDLE_PER_WAVE;
__device__ __forceinline__ void ffn_transpose_item(const float* w_gate, const float* w_up, const float* w_down, bf16* Wgu_t, bf16* Wd_t, LAS float* scr, int r, int lane) {
    if (r < I_FG) { p0_transpose_item(w_gate, DM, FF, FF, Wgu_t, scr, r / (FF / 32), r % (FF / 32), lane, RmGate{0}); return; } r -= I_FG;
    if (r < I_FG) { p0_transpose_item(w_up, DM, FF, FF, Wgu_t, scr, r / (FF / 32), r % (FF / 32), lane, RmGate{128}); return; } r -= I_FG;
    p0_transpose_item(w_down, FF, DM, DM, Wd_t, scr, r / (DM / 32), r % (DM / 32), lane, RmId{});
}
struct FfnHook {
    const float *w_gate, *w_up, *w_down; bf16 *Wgu_t, *Wd_t; int gw, NGW;
    __device__ __forceinline__ void operator()(int slot, LAS unsigned char* scr, int lane) const {
        if (slot > 3) return;
        if (slot > 2) return;
        const int it = N_FFN_P2 + gw + NGW * slot; if (it < 2 * I_FG) ffn_transpose_item(w_gate, w_up, w_down, Wgu_t, Wd_t, (LAS float*)scr, it, lane);
    }
};
__device__ __forceinline__ void p0_prologue(Frame& F, const Args& A) {
    const float* c = (const float*)A.in[1]; const int* pos = (const int*)A.in[2]; const float* w_ada = (const float*)A.in[3];
    const float* w_in = (const float*)A.in[9]; const float* w_o = (const float*)A.in[15]; const float* w_gate = (const float*)A.in[16]; const float* w_up = (const float*)A.in[17]; const float* w_down = (const float*)A.in[18];
    unsigned char* ws = A.ws;
    bf16* Win_t = (bf16*)(ws + WS_WIN); bf16* Wo_t = (bf16*)(ws + WS_WO); bf16* Wgu_t = (bf16*)(ws + WS_WGU); bf16* Wd_t = (bf16*)(ws + WS_WD);
    float* MODP = (float*)(ws + WS_MODP); float* ROPE = (float*)(ws + WS_ROPE);
    const int gw = F.vcu * NWAVES + F.wave, NGW = F.G * NWAVES;
    for (int g = F.vcu * 512 + F.tid; g < M * 24; g += F.G * 512) {
        const int m = g / 24, i = g % 24; const float p = (float)pos[m];
        if (i < 8) { const float inv = powf(500000.f, -((float)(2 * i) / 16.f)); const float a = p * inv; ROPE[m * 48 + i] = cosf(a); ROPE[m * 48 + 8 + i] = sinf(a); }
        else { const int k = i - 8; const float inv = powf(500000.f, -((float)(2 * k) / 32.f)); const float a = p * inv; ROPE[m * 48 + 16 + k] = cosf(a); ROPE[m * 48 + 32 + k] = sinf(a); }
    }
    constexpr int KR = DM / ADA_KC;
    constexpr int N_ADA = ADA_KC * (NADA / 256);
    LAS float* scr = (LAS float*)(F.lds + RING_OFF + F.wave * 16384);
#ifdef PROBE_ADA2
    for (int rep = 0; rep < 2; ++rep)
#endif
    for (int it = gw; it < N_ADA; it += NGW) {
        const int kc = it / (NADA / 256), cc = it % (NADA / 256);
#pragma unroll
        for (int j = 0; j < 4; ++j) { const int idx = F.lane + 64 * j; const int b = idx >> 7, k = idx & 127; const float v = c[b * DM + kc * KR + k]; scr[idx] = v / (1.f + expf(-v)); }
        LDS_WAIT(); asm volatile("" ::: "memory");
        const float* wp = w_ada + (size_t)(kc * KR) * NADA + cc * 256 + 4 * F.lane;
        f32x4 a0 = {0.f, 0.f, 0.f, 0.f}, a1 = {0.f, 0.f, 0.f, 0.f};
#pragma unroll 8
        for (int k = 0; k < KR; ++k) { const f32x4 w = *(const GAS f32x4*)(wp + (size_t)k * NADA); const float s0 = scr[k], s1 = scr[128 + k]; a0 += w * s0; a1 += w * s1; }
        *(GAS f32x4*)(MODP + (size_t)(kc * 2 + 0) * NADA + cc * 256 + 4 * F.lane) = a0;
        *(GAS f32x4*)(MODP + (size_t)(kc * 2 + 1) * NADA + cc * 256 + 4 * F.lane) = a1;
        LDS_WAIT(); asm volatile("" ::: "memory");
    }
    constexpr int I_IN = 32 * (NPROJ_PAD / 32), I_O = 32 * (DM / 32), I_G = 32 * (FF / 32), I_D = (FF / 64) * (DM / 32);
    const bool ffn_later = (F.G == 256);
    const int NT_ITEMS = ffn_later ? I_IN + I_O : I_IN + I_O + 2 * I_G + I_D;
    const int ADA_SHARE = ffn_later ? 0 : 8;
    int it, step, end;
    if (NGW > N_ADA) { if (gw < N_ADA) { it = gw; step = N_ADA; end = N_ADA * ADA_SHARE; } else { it = N_ADA * ADA_SHARE + (gw - N_ADA); step = NGW - N_ADA; end = NT_ITEMS; } }
    else { it = gw; step = NGW; end = NT_ITEMS; }
#ifdef PROBE_TR2
    const int it0 = it;
    for (int rep = 0; rep < 2; ++rep)
    for (it = it0; it < end; it += step) {
#else
    for (; it < end; it += step) {
#endif
        int r = it;
        if (r < I_IN) { p0_transpose_item(w_in, DM, NPROJ, NPROJ, Win_t, scr, r / (NPROJ_PAD / 32), r % (NPROJ_PAD / 32), F.lane, RmId{}); continue; } r -= I_IN;
        if (r < I_O)  { p0_transpose_item(w_o, DM, DM, DM, Wo_t, scr, r / (DM / 32), r % (DM / 32), F.lane, RmId{}); continue; } r -= I_O;
        if (r < I_G)  { p0_transpose_item(w_gate, DM, FF, FF, Wgu_t, scr, r / (FF / 32), r % (FF / 32), F.lane, RmGate{0}); continue; } r -= I_G;
        if (r < I_G)  { p0_transpose_item(w_up, DM, FF, FF, Wgu_t, scr, r / (FF / 32), r % (FF / 32), F.lane, RmGate{128}); continue; } r -= I_G;
        p0_transpose_item(w_down, FF, DM, DM, Wd_t, scr, r / (DM / 32), r % (DM / 32), F.lane, RmId{});
    }
}
__device__ __forceinline__ void p1_norm(Frame& F, const Args& A) {
    const float* x = (const float*)A.in[0]; const float* b_ada = (const float*)A.in[4]; const float* g_pre = (const float*)A.in[5];
    unsigned char* ws = A.ws; const float* MODP = (const float*)(ws + WS_MODP); float* MOD = (float*)(ws + WS_MOD); bf16* XN = (bf16*)(ws + WS_XN);
    LAS float* sv = (LAS float*)(F.lds + RING_OFF);
    const int rows_per_wg = M / F.G;
    const int m0 = F.vcu * rows_per_wg, b = m0 / SEQ;
    for (int i = F.tid; i < 2 * DM; i += 512) { float s = b_ada[i];
#pragma unroll 4
        for (int kc = 0; kc < ADA_KC; ++kc) s += MODP[(size_t)(kc * 2 + b) * NADA + i];
        sv[i] = s; }
    { const int per = (BATCH * NADA + F.G - 1) / F.G;
      for (int i = F.tid; i < per; i += 512) { const int idx = F.vcu * per + i; if (idx < BATCH * NADA) { const int bb = idx / NADA, j = idx % NADA; float s = b_ada[j];
#pragma unroll 4
            for (int kc = 0; kc < ADA_KC; ++kc) s += MODP[(size_t)(kc * 2 + bb) * NADA + j];
            MOD[idx] = s; } } }
    LDS_WAIT(); __syncthreads();
    for (int r = F.wave; r < rows_per_wg; r += NWAVES) {
        const int m = m0 + r;
        const GAS f32x4* xr = (const GAS f32x4*)(x + (size_t)m * DM) + F.lane;
        f32x4 v[8]; float s = 0.f;
#pragma unroll
        for (int j = 0; j < 8; ++j) { v[j] = xr[64 * j]; s += (v[j].x * v[j].x + v[j].y * v[j].y) + (v[j].z * v[j].z + v[j].w * v[j].w); }
        const float rstd = 1.0f / sqrtf(wave_sum(s) * (1.f / DM) + RMS_EPS);
        GAS unsigned long long* o8 = (GAS unsigned long long*)(XN + (size_t)m * DM) + F.lane;
#pragma unroll
        for (int j = 0; j < 8; ++j) { const int col = 4 * F.lane + 256 * j; const f32x4 g = *(const GAS f32x4*)(g_pre + col);
            const f32x4 sh = *(const LAS f32x4*)(sv + col), sc = *(const LAS f32x4*)(sv + DM + col);
            const f32x4 o = v[j] * rstd * g * (sc + 1.0f) + sh;
            o8[64 * j] = (unsigned long long)pk2(o.x, o.y) | ((unsigned long long)pk2(o.z, o.w) << 32); }
    }
}


__device__ __forceinline__ void p6_post1(Frame& F, const Args& A) {
    const float* x = (const float*)A.in[0]; const float* g_post = (const float*)A.in[6]; const float* g_pre2 = (const float*)A.in[7];
    unsigned char* ws = A.ws; const float* MOD = (const float*)(ws + WS_MOD); const bf16* MIXOUT = (const bf16*)(ws + WS_MIXOUT); bf16* XN = (bf16*)(ws + WS_XN); float* X1 = A.out;
    LAS float* A1 = (LAS float*)(F.lds + RING_OFF); LAS float* A2 = A1 + DM; LAS float* A3 = A2 + DM;
    const int rows_per_wg = M / F.G; const int m0 = F.vcu * rows_per_wg, b = m0 / SEQ; const float* md = MOD + (size_t)b * NADA;
    for (int j = F.tid; j < DM; j += 512) { A1[j] = md[2 * DM + j] * g_post[j]; A2[j] = g_pre2[j] * (1.0f + md[4 * DM + j]); A3[j] = md[3 * DM + j]; }
    LDS_WAIT(); __syncthreads();
    for (int r = F.wave; r < rows_per_wg; r += NWAVES) {
        const int m = m0 + r;
        const GAS unsigned long long* mr = (const GAS unsigned long long*)(MIXOUT + (size_t)m * DM) + F.lane; const GAS f32x4* xr = (const GAS f32x4*)(x + (size_t)m * DM) + F.lane;
        GAS f32x4* o1 = (GAS f32x4*)(X1 + (size_t)m * DM) + F.lane;
        f32x4 v[8]; float s = 0.f;
#pragma unroll
        for (int j = 0; j < 8; ++j) { const unsigned long long w = mr[64 * j]; const unsigned lo = (unsigned)w, hi = (unsigned)(w >> 32);
            v[j] = (f32x4){__uint_as_float(lo << 16), __uint_as_float(lo & 0xffff0000u), __uint_as_float(hi << 16), __uint_as_float(hi & 0xffff0000u)};
            s += (v[j].x * v[j].x + v[j].y * v[j].y) + (v[j].z * v[j].z + v[j].w * v[j].w); }
        const float rstd = 1.0f / sqrtf(wave_sum(s) * (1.f / DM) + RMS_EPS);
        float s2 = 0.f;
#pragma unroll
        for (int j = 0; j < 8; ++j) { const int col = 4 * F.lane + 256 * j; const f32x4 a1 = *(const LAS f32x4*)(A1 + col);
            v[j] = xr[64 * j] + (v[j] * rstd) * a1; o1[64 * j] = v[j]; s2 += (v[j].x * v[j].x + v[j].y * v[j].y) + (v[j].z * v[j].z + v[j].w * v[j].w); }
        const float rstd2 = 1.0f / sqrtf(wave_sum(s2) * (1.f / DM) + RMS_EPS);
        GAS unsigned long long* o8 = (GAS unsigned long long*)(XN + (size_t)m * DM) + F.lane;
#pragma unroll
        for (int j = 0; j < 8; ++j) { const int col = 4 * F.lane + 256 * j; const f32x4 a2 = *(const LAS f32x4*)(A2 + col), a3 = *(const LAS f32x4*)(A3 + col);
            const f32x4 o = (v[j] * rstd2) * a2 + a3;
            o8[64 * j] = (unsigned long long)pk2(o.x, o.y) | ((unsigned long long)pk2(o.z, o.w) << 32); }
    }
}
__device__ __forceinline__ void p9_post2(Frame& F, const Args& A) {
    const float* g_post = (const float*)A.in[8];
    unsigned char* ws = A.ws; const float* MOD = (const float*)(ws + WS_MOD); const bf16* FFO = (const bf16*)(ws + WS_FFO); float* X1 = A.out;
    LAS float* A1 = (LAS float*)(F.lds + RING_OFF);
    const int rows_per_wg = M / F.G; const int m0 = F.vcu * rows_per_wg, b = m0 / SEQ; const float* md = MOD + (size_t)b * NADA;
    for (int j = F.tid; j < DM; j += 512) A1[j] = md[5 * DM + j] * g_post[j];
    LDS_WAIT(); __syncthreads();
    for (int r = F.wave; r < rows_per_wg; r += NWAVES) {
        const int m = m0 + r;
        const GAS unsigned long long* fr = (const GAS unsigned long long*)(FFO + (size_t)m * DM) + F.lane; GAS f32x4* o1 = (GAS f32x4*)(X1 + (size_t)m * DM) + F.lane;
        f32x4 v[8]; float s = 0.f;
#pragma unroll
        for (int j = 0; j < 8; ++j) { const unsigned long long w = fr[64 * j]; const unsigned lo = (unsigned)w, hi = (unsigned)(w >> 32);
            v[j] = (f32x4){__uint_as_float(lo << 16), __uint_as_float(lo & 0xffff0000u), __uint_as_float(hi << 16), __uint_as_float(hi & 0xffff0000u)};
            s += (v[j].x * v[j].x + v[j].y * v[j].y) + (v[j].z * v[j].z + v[j].w * v[j].w); }
        const float rstd = 1.0f / sqrtf(wave_sum(s) * (1.f / DM) + RMS_EPS);
#pragma unroll
        for (int j = 0; j < 8; ++j) { const int col = 4 * F.lane + 256 * j; const f32x4 a1 = *(const LAS f32x4*)(A1 + col); o1[64 * j] = o1[64 * j] + (v[j] * rstd) * a1; }
    }
}


__device__ __forceinline__ void p4_combine(Frame& F, const Args& A) {
    const float* lq1 = (const float*)A.in[10]; const float* lk1 = (const float*)A.in[11]; const float* lq2 = (const float*)A.in[12]; const float* lk2 = (const float*)A.in[13]; const float* g_diff = (const float*)A.in[14];
    unsigned char* ws = A.ws; const bf16* O1 = (const bf16*)(ws + WS_O1); const bf16* O2 = (const bf16*)(ws + WS_O2); bf16* MIX = (bf16*)(ws + WS_MIX);
    const float lam = expf(wave_sum(lq1[F.lane] * lk1[F.lane])) - expf(wave_sum(lq2[F.lane] * lk2[F.lane])) + 0.2f;
    float gd[16];
#pragma unroll
    for (int i = 0; i < 4; ++i) { const f32x4 g4 = *(const GAS f32x4*)(g_diff + 16 * (F.lane & 7) + 4 * i); gd[4 * i] = g4.x * 0.8f; gd[4 * i + 1] = g4.y * 0.8f; gd[4 * i + 2] = g4.z * 0.8f; gd[4 * i + 3] = g4.w * 0.8f; }
    const int gw = F.vcu * NWAVES + F.wave, NGW = F.G * NWAVES;
    for (int m = gw; m < M; m += NGW) {
        const GAS v4u* p1 = (const GAS v4u*)(O1 + (size_t)m * 1024 + 16 * F.lane); const GAS v4u* p2 = (const GAS v4u*)(O2 + (size_t)m * 1024 + 16 * F.lane);
        const v4u a0 = p1[0], a1 = p1[1], b0 = p2[0], b1 = p2[1];
        const unsigned aw[8] = {a0.x, a0.y, a0.z, a0.w, a1.x, a1.y, a1.z, a1.w}, bw[8] = {b0.x, b0.y, b0.z, b0.w, b1.x, b1.y, b1.z, b1.w};
        float d[16]; float ss = 0.f;
#pragma unroll
        for (int i = 0; i < 8; ++i) { d[2 * i] = __uint_as_float(aw[i] << 16) - lam * __uint_as_float(bw[i] << 16); d[2 * i + 1] = __uint_as_float(aw[i] & 0xffff0000u) - lam * __uint_as_float(bw[i] & 0xffff0000u);
            ss += d[2 * i] * d[2 * i] + d[2 * i + 1] * d[2 * i + 1]; }
        ss += __shfl_xor(ss, 1); ss += __shfl_xor(ss, 2); ss += __shfl_xor(ss, 4);
        const float rstd = 1.0f / sqrtf(ss * (1.f / 128.f) + RMS_EPS);
        v4u o0, o1;
        o0.x = pk2(d[0] * rstd * gd[0], d[1] * rstd * gd[1]); o0.y = pk2(d[2] * rstd * gd[2], d[3] * rstd * gd[3]); o0.z = pk2(d[4] * rstd * gd[4], d[5] * rstd * gd[5]); o0.w = pk2(d[6] * rstd * gd[6], d[7] * rstd * gd[7]);
        o1.x = pk2(d[8] * rstd * gd[8], d[9] * rstd * gd[9]); o1.y = pk2(d[10] * rstd * gd[10], d[11] * rstd * gd[11]); o1.z = pk2(d[12] * rstd * gd[12], d[13] * rstd * gd[13]); o1.w = pk2(d[14] * rstd * gd[14], d[15] * rstd * gd[15]);
        GAS v4u* po = (GAS v4u*)(MIX + (size_t)m * 2048 + 16 * F.lane); po[0] = o0; po[1] = o1;
    }
}

__global__ void __launch_bounds__(NWAVES * 64, 2) mega_fwd(Args args) {
    extern __shared__ __attribute__((aligned(16))) unsigned char lds[];
    Frame F;
    F.lds = (LAS unsigned char*)lds;
    F.MISC = (volatile LAS unsigned*)(F.lds + MISC_OFF);
    F.tid = threadIdx.x; F.lane = 0; F.wave = 0;
    F.G = gridDim.x; { const int bx = blockIdx.x; F.vcu = (F.G % 8 == 0) ? (bx % 8) * (F.G / 8) + bx / 8 : bx; }
    unsigned char* ws = args.ws;
    F.ctl = (gu32*)(ws + WS_CTL);
    for (int u = F.tid; u < (LDS_BYTES - LDSCTL_OFF) / 4; u += NWAVES * 64) ((LAS unsigned*)(F.lds + LDSCTL_OFF))[u] = 0u;
    __syncthreads();
    XcdBarrier bar = xcd_barrier_post((unsigned*)(F.ctl + CW_BAR), F.MISC + 8);
    const int lo = args.ph_lo, hi = args.ph_hi;
#define IN(k) (lo <= (k) && (k) < hi)
#define FRESH(Fk) Frame Fk = F; asm volatile("" : "+v"(Fk.tid)); Fk.lane = Fk.tid & 63; Fk.wave = __builtin_amdgcn_readfirstlane(Fk.tid >> 6)
#define BOTH(k) (IN(k) && IN((k) + 1))
    bf16 *XN = (bf16*)(ws + WS_XN), *Win_t = (bf16*)(ws + WS_WIN);

    if (IN(0)) { FRESH(F0); p0_prologue(F0, args); if (BOTH(0)) xcd_barrier(bar); }
    if (IN(1)) { FRESH(F1); p1_norm(F1, args); if (BOTH(1)) xcd_barrier(bar); }
    if (IN(2)) {
        pg8::Gemm g{XN, Win_t, M, NPROJ_PAD, DM}; pg8::StaticOrder S; S.init(M, NPROJ_PAD, F.G, (int)blockIdx.x);
        pg8::EpiProj E{(bf16*)(ws + WS_QD), (bf16*)(ws + WS_KD), (bf16*)(ws + WS_VD), (bf16*)(ws + WS_QS), (bf16*)(ws + WS_KS), (bf16*)(ws + WS_VS), (bf16*)(ws + WS_QI), (bf16*)(ws + WS_KI), (float*)(ws + WS_WI), (const float*)(ws + WS_ROPE), ws + WS_KS8, ws + WS_VS8};
        pg8::gemm_phase<pg8::EpiProj, pg8::StaticOrder, true, true>(F.lds + RING_OFF, g, S, E);
        if (F.G == 256 && (int)blockIdx.x >= P2_IDLE_FIRST) {
            FRESH(F2);
            LAS float* scr2 = (LAS float*)(F2.lds + RING_OFF + F2.wave * 16384);
            const int base = (((int)blockIdx.x - P2_IDLE_FIRST) * NWAVES + F2.wave) * P2_IDLE_PER_WAVE;
            for (int j = 0; j < P2_IDLE_PER_WAVE; ++j) ffn_transpose_item((const float*)args.in[16], (const float*)args.in[17], (const float*)args.in[18], (bf16*)(ws + WS_WGU), (bf16*)(ws + WS_WD), scr2, base + j, F2.lane);
        }
        if (BOTH(2)) xcd_barrier(bar);
    }
    if (IN(3)) {
        static_assert(attn_body::ATTN_LDS_BYTES <= RING_BYTES, "attention LDS");
        const attn_body::AttnTensors AT{(const attn_body::bf16*)(ws + WS_QD), (const attn_body::bf16*)(ws + WS_KD), (const attn_body::bf16*)(ws + WS_VD), (attn_body::bf16*)(ws + WS_O1), (attn_body::bf16*)(ws + WS_O2)};
        const attn_body::StaticOrder S((int)F.G, F.vcu);
        attn_body::attn_phase<attn_body::StaticOrder>((char*)lds + RING_OFF, AT, S);
        if (BOTH(3)) xcd_barrier(bar);
    }
    if (IN(4)) {
        static_assert(dsa_body::L_TOTAL <= RING_BYTES, "dsa LDS");
        const dsa_body::DsaTensors DT{(const bf16*)(ws + WS_QI), (const bf16*)(ws + WS_KI), (const float*)(ws + WS_WI), (const bf16*)(ws + WS_QS), (const bf16*)(ws + WS_KS), (const bf16*)(ws + WS_VS), (bf16*)(ws + WS_MIX), (float*)(ws + WS_SCORES), ws + WS_KS8, ws + WS_VS8};
        FRESH(F4);
#ifndef NO_DSA
        const FfnHook hook{(const float*)args.in[16], (const float*)args.in[17], (const float*)args.in[18], (bf16*)(ws + WS_WGU), (bf16*)(ws + WS_WD), F4.vcu * NWAVES + F4.wave, F4.G * NWAVES};
        dsa_body::dsa_phase(F4.lds + RING_OFF, DT, F4.vcu, F4.G, F4.tid, F4.wave, F4.lane, hook);
#endif
#ifndef NO_COMBINE
        p4_combine(F4, args);
#endif
        if (BOTH(4)) xcd_barrier(bar);
    }
    if (IN(5)) {
        pg8::Gemm g{(bf16*)(ws + WS_MIX), (bf16*)(ws + WS_WO), M, DM, DM}; pg8::StaticOrder S; S.init(M, DM, F.G, (int)blockIdx.x);
        pg8::EpiBf16P E{(bf16*)(ws + WS_MIXOUT), DM};
        pg8::gemm_phase<pg8::EpiBf16P, pg8::StaticOrder, true, true>(F.lds + RING_OFF, g, S, E);
        if (BOTH(5)) xcd_barrier(bar);
    }
    if (IN(6)) { FRESH(F6); p6_post1(F6, args); if (BOTH(6)) xcd_barrier(bar); }
    if (IN(7)) {
        pg8::Gemm g{XN, (bf16*)(ws + WS_WGU), M, 2 * FF, DM}; pg8::StaticOrder S; S.init(M, 2 * FF, F.G, (int)blockIdx.x);
        pg8::EpiSwi E{(bf16*)(ws + WS_ACT), FF};
        pg8::gemm_phase<pg8::EpiSwi, pg8::StaticOrder, true, true>(F.lds + RING_OFF, g, S, E);
        if (F.G == 256 && (int)blockIdx.x >= 128) {
            FRESH(F7);
            LAS float* scr7 = (LAS float*)(F7.lds + RING_OFF + F7.wave * 16384);
            const int w7 = ((int)blockIdx.x - 128) * NWAVES + F7.wave;
            for (int it = 2 * I_FG + w7; it < N_FFN_ITEMS; it += 128 * NWAVES) ffn_transpose_item((const float*)args.in[16], (const float*)args.in[17], (const float*)args.in[18], (bf16*)(ws + WS_WGU), (bf16*)(ws + WS_WD), scr7, it, F7.lane);
        }
        if (BOTH(7)) xcd_barrier(bar);
    }
    if (IN(8)) {
        pg8::Gemm g{(bf16*)(ws + WS_ACT), (bf16*)(ws + WS_WD), M, DM, FF}; pg8::StaticOrder S; S.init(M, DM, F.G, (int)blockIdx.x);
        pg8::EpiBf16P E{(bf16*)(ws + WS_FFO), DM};
        pg8::gemm_phase<pg8::EpiBf16P, pg8::StaticOrder, true, true>(F.lds + RING_OFF, g, S, E);
        if (BOTH(8)) xcd_barrier(bar);
    }
    if (IN(9)) { FRESH(F9); p9_post2(F9, args); }
#undef IN
#undef BOTH
}

extern "C" void kernel_launch(void* const* d_in, const int* in_sizes, int n_in, void* d_out, int out_size, void* d_ws, size_t ws_size, hipStream_t stream) {
    static int grid = 0;
    if (grid == 0) {
        if (n_in != 19 || in_sizes[0] != M * DM || out_size != M * DM || ws_size < WS_END) { fprintf(stderr, "kernel_launch: built for 19 inputs, x and out of %d floats, >= %zu bytes of workspace; got n_in %d, out %d, ws %zu; nothing launched\n", M * DM, (size_t)WS_END, n_in, out_size, ws_size); grid = -1; return; }
        int dev = 0, cus = 0, per_cu = 0;
        if (hipGetDevice(&dev) != hipSuccess || hipDeviceGetAttribute(&cus, hipDeviceAttributeMultiprocessorCount, dev) != hipSuccess) { fprintf(stderr, "kernel_launch: hipGetDevice / hipDeviceGetAttribute failed; nothing launched\n"); grid = -1; return; }
        if (hipFuncSetAttribute((const void*)mega_fwd, hipFuncAttributeMaxDynamicSharedMemorySize, LDS_BYTES) != hipSuccess) { fprintf(stderr, "kernel_launch: hipFuncSetAttribute failed (%d bytes of dynamic LDS per workgroup); nothing launched\n", LDS_BYTES); grid = -1; return; }
        if (hipOccupancyMaxActiveBlocksPerMultiprocessor(&per_cu, (const void*)mega_fwd, NWAVES * 64, LDS_BYTES) != hipSuccess || per_cu < 1) fprintf(stderr, "kernel_launch: note: the occupancy query reports %d workgroups per CU\n", per_cu);
        (void)hipGetLastError();
        grid = cus;
    }
    if (grid < 0) return;
    if (hipMemsetAsync((char*)d_ws + WS_CTL, 0, CTL_ZERO_BYTES, stream) != hipSuccess) { fprintf(stderr, "kernel_launch: hipMemsetAsync of the control words failed; nothing launched\n"); return; }
    Args a{};
    for (int i = 0; i < 19; ++i) a.in[i] = d_in[i];
    a.out = (float*)d_out; a.ws = (unsigned char*)d_ws; a.ph_lo = 0; a.ph_hi = 10;
    hipLaunchKernelGGL(mega_fwd, dim3(grid), dim3(NWAVES * 64), LDS_BYTES, stream, a);
}
```
